# Optimizing an MI355X kernel written in HIP

```python
import math
import jax, jax.numpy as jnp
from jax import lax
import numpy as np

D_MODEL = 1024
BATCH = 4
SEQ = 8192
DEPTH = 4

MIX_WIDTH = 2 * D_MODEL
RET_WIDTH = MIX_WIDTH // 4
SSD_WIDTH = MIX_WIDTH // 2
FOX_WIDTH = MIX_WIDTH // 4
RET_HEAD_DIM = 128
RET_HEADS = RET_WIDTH // RET_HEAD_DIM
SSD_HEAD_DIM = 64
SSD_HEADS = SSD_WIDTH // SSD_HEAD_DIM
SSD_GROUPS = 2
SSD_STATE = 128
CONV_K = 4
CONV_DIM = SSD_WIDTH + 2 * SSD_GROUPS * SSD_STATE
FOX_HEAD_DIM = 64
FOX_HEADS = FOX_WIDTH // FOX_HEAD_DIM
CHUNK = 128
Q_BLOCK = 128
ROPE_BASE = 10000.0
EPS = 1e-6

IN_SIZES = (RET_WIDTH, RET_WIDTH, RET_WIDTH, RET_WIDTH,
            CONV_DIM, SSD_HEADS, SSD_WIDTH,
            FOX_WIDTH, FOX_WIDTH, FOX_WIDTH, FOX_WIDTH,
            FOX_HEADS)
N_IN = sum(IN_SIZES)
IN_OFFSETS = tuple(int(v) for v in np.cumsum(IN_SIZES)[:-1])

kernel_name = "hymba_style_retention_ssd_fox_trunk"


def _rmsnorm(t, gain=None):
    t32 = t.astype(jnp.float32)
    t32 = t32 * lax.rsqrt(jnp.mean(t32 * t32, axis=-1, keepdims=True) + EPS)
    if gain is not None:
        t32 = t32 * gain.astype(jnp.float32)
    return t32.astype(t.dtype)


def _rotary(t, positions):
    half = t.shape[-1] // 2
    freq = ROPE_BASE ** (-jnp.arange(half, dtype=jnp.float32) / half)
    ang = positions.astype(jnp.float32)[..., None] * freq
    cos = jnp.cos(ang)[:, :, None, :]
    sin = jnp.sin(ang)[:, :, None, :]
    t1 = t[..., :half].astype(jnp.float32)
    t2 = t[..., half:].astype(jnp.float32)
    return jnp.concatenate([t1 * cos - t2 * sin, t1 * sin + t2 * cos], axis=-1).astype(t.dtype)


def _retention(q, k, v, positions):
    b, L, H, dh = q.shape
    n = L // CHUNK
    q = _rotary(q, positions)
    k = _rotary(k, positions) * (dh ** -0.5)
    log_g = jnp.log(1.0 - 2.0 ** (-5.0 - jnp.arange(H, dtype=jnp.float32)))
    idx = jnp.arange(CHUNK, dtype=jnp.float32)
    diff = idx[:, None] - idx[None, :]
    decay_intra = jnp.where(diff >= 0, jnp.exp(log_g[:, None, None] * jnp.maximum(diff, 0.0)), 0.0)
    decay_q = jnp.exp(log_g[:, None] * (idx + 1.0))
    decay_k = jnp.exp(log_g[:, None] * (CHUNK - 1.0 - idx))
    decay_chunk = jnp.exp(log_g * CHUNK)

    def to_chunks(t):
        return t.reshape(b, n, CHUNK, H, dh).transpose(1, 0, 3, 2, 4)

    def step(S, inp):
        qc, kc, vc = inp
        s = jnp.einsum('bhid,bhjd->bhij', qc, kc) * decay_intra
        o = (jnp.einsum('bhij,bhjd->bhid', s, vc)
             + jnp.einsum('bhid,bhde->bhie', qc, S) * decay_q[:, :, None])
        S = S * decay_chunk[:, None, None] + jnp.einsum('bhjd,hj,bhje->bhde', kc, decay_k, vc)
        return S, o

    S0 = jnp.zeros((b, H, dh, dh), jnp.float32)
    _, o = lax.scan(step, S0, (to_chunks(q), to_chunks(k), to_chunks(v)))
    o = o.transpose(1, 0, 3, 2, 4).reshape(b, L, H, dh)
    return _rmsnorm(o).astype(v.dtype)


def _ssd(xs, dt, A, Bm, Cm):
    b, L, H, P = xs.shape
    G, N = Bm.shape[2], Bm.shape[3]
    hpg = H // G
    n = L // CHUNK
    a = (dt * A).astype(jnp.float32)
    xdt = xs * dt[..., None]
    xc_all = xdt.reshape(b, n, CHUNK, G, hpg, P).transpose(1, 0, 2, 3, 4, 5)
    a_all = a.reshape(b, n, CHUNK, G, hpg).transpose(1, 0, 3, 4, 2)
    b_all = Bm.reshape(b, n, CHUNK, G, N).transpose(1, 0, 2, 3, 4)
    c_all = Cm.reshape(b, n, CHUNK, G, N).transpose(1, 0, 2, 3, 4)
    causal = jnp.tril(jnp.ones((CHUNK, CHUNK), dtype=bool))

    def step(S, inp):
        xc, ac, bc, cc = inp
        acum = jnp.cumsum(ac, axis=-1)
        seg = acum[..., :, None] - acum[..., None, :]
        Lm = jnp.exp(jnp.where(causal, seg, -jnp.inf))
        cb = jnp.einsum('bign,bjgn->bgij', cc, bc)
        y = jnp.einsum('bgij,bghij,bjghp->bighp', cb, Lm, xc)
        y = y + jnp.einsum('bign,bghpn,bghi->bighp', cc, S, jnp.exp(acum))
        last = acum[..., -1:]
        S = (S * jnp.exp(last)[..., None]
             + jnp.einsum('bjgn,bghj,bjghp->bghpn', bc, jnp.exp(last - acum), xc))
        return S, y

    S0 = jnp.zeros((b, G, hpg, P, N), jnp.float32)
    _, y = lax.scan(step, S0, (xc_all, a_all, b_all, c_all))
    return y.transpose(1, 0, 2, 3, 4, 5).reshape(b, L, H, P)


def _causal_dwconv(u, w, bias):
    out = lax.conv_general_dilated(
        u, w[:, None, :].astype(u.dtype), window_strides=(1,), padding=[(CONV_K - 1, 0)],
        dimension_numbers=('NWC', 'WIO', 'NWC'), feature_group_count=u.shape[-1])
    return out + bias


def _forgetting_attention(q, k, v, log_f):
    b, L, H, dh = q.shape
    nb = L // Q_BLOCK
    Ft = jnp.cumsum(log_f.astype(jnp.float32), axis=1).transpose(0, 2, 1)
    q_blocks = q.reshape(b, nb, Q_BLOCK, H, dh).transpose(1, 0, 2, 3, 4)
    f_blocks = Ft.reshape(b, H, nb, Q_BLOCK).transpose(2, 0, 1, 3)
    kpos = jnp.arange(L)
    scale = dh ** -0.5

    def block(inp):
        qi, fi, i = inp
        s = jnp.einsum('bqhd,bkhd->bhqk', qi, k).astype(jnp.float32) * scale
        s = s + fi[..., None] - Ft[:, :, None, :]
        qpos = i * Q_BLOCK + jnp.arange(Q_BLOCK)
        s = jnp.where(qpos[:, None] >= kpos[None, :], s, -jnp.inf)
        p = jax.nn.softmax(s, axis=-1)
        return jnp.einsum('bhqk,bkhd->bqhd', p.astype(v.dtype), v)

    o = lax.map(block, (q_blocks, f_blocks, jnp.arange(nb)))
    return o.transpose(1, 0, 2, 3, 4).reshape(b, L, H, dh)


def _layer(x, c, positions, norm_g, w_ada, b_ada, w_in, conv_w, conv_b,
           dt_bias, a_log, d_skip, ssd_norm_g, b_forget, w_out):
    b, L, _ = x.shape
    mod = jax.nn.silu(c) @ w_ada + b_ada
    shift, scale, gate = jnp.split(mod, 3, axis=-1)
    h = _rmsnorm(x, norm_g) * (1.0 + scale[:, None, :]) + shift[:, None, :]

    proj = h @ w_in
    (rq, rk, rv, rg, xbc, dt_raw, z, fq, fk, fv, fg, f_raw) = jnp.split(proj, IN_OFFSETS, axis=-1)

    ret = _retention(rq.reshape(b, L, RET_HEADS, RET_HEAD_DIM),
                     rk.reshape(b, L, RET_HEADS, RET_HEAD_DIM),
                     rv.reshape(b, L, RET_HEADS, RET_HEAD_DIM), positions)
    ret = ret.reshape(b, L, RET_WIDTH) * jax.nn.silu(rg)

    xbc = jax.nn.silu(_causal_dwconv(xbc, conv_w, conv_b))
    xs, Bm, Cm = jnp.split(xbc, (SSD_WIDTH, SSD_WIDTH + SSD_GROUPS * SSD_STATE), axis=-1)
    xs = xs.reshape(b, L, SSD_HEADS, SSD_HEAD_DIM)
    Bm = Bm.reshape(b, L, SSD_GROUPS, SSD_STATE)
    Cm = Cm.reshape(b, L, SSD_GROUPS, SSD_STATE)
    dt = jax.nn.softplus(dt_raw + dt_bias)
    A = -jnp.exp(a_log.astype(jnp.float32))
    y = _ssd(xs, dt, A, Bm, Cm) + d_skip[:, None] * xs
    ssd = _rmsnorm(y.reshape(b, L, SSD_WIDTH).astype(x.dtype) * jax.nn.silu(z), ssd_norm_g)

    log_f = jax.nn.log_sigmoid((f_raw + b_forget).astype(jnp.float32))
    fox = _forgetting_attention(fq.reshape(b, L, FOX_HEADS, FOX_HEAD_DIM),
                                fk.reshape(b, L, FOX_HEADS, FOX_HEAD_DIM),
                                fv.reshape(b, L, FOX_HEADS, FOX_HEAD_DIM), log_f)
    fox = fox.reshape(b, L, FOX_WIDTH) * jax.nn.silu(fg)

    mixed = jnp.concatenate([ret.astype(x.dtype), ssd.astype(x.dtype), fox.astype(x.dtype)], axis=-1)
    out = mixed @ w_out
    return x + gate[:, None, :] * out


def setup_inputs(seed: int = 0) -> dict:
    key = jax.random.key(seed)
    ks = jax.random.split(key, 16)
    f32 = jnp.float32
    x = jax.random.normal(ks[0], (BATCH, SEQ, D_MODEL), f32)
    c = jax.random.normal(ks[1], (BATCH, D_MODEL), f32)
    offsets = jax.random.randint(ks[2], (BATCH, 1), 0, 4096, dtype=jnp.int32)
    positions = (jnp.arange(SEQ, dtype=jnp.int32)[None, :] + offsets).astype(jnp.int32)
    norm_g = 1.0 + 0.02 * jax.random.normal(ks[3], (DEPTH, D_MODEL), f32)
    w_ada = 0.5 * D_MODEL ** -0.5 * jax.random.normal(ks[4], (DEPTH, D_MODEL, 3 * D_MODEL), f32)
    b_ada = 0.02 * jax.random.normal(ks[5], (DEPTH, 3 * D_MODEL), f32)
    w_in = D_MODEL ** -0.5 * jax.random.normal(ks[6], (DEPTH, D_MODEL, N_IN), f32)
    conv_w = CONV_K ** -0.5 * jax.random.normal(ks[7], (DEPTH, CONV_K, CONV_DIM), f32)
    conv_b = 0.02 * jax.random.normal(ks[8], (DEPTH, CONV_DIM), f32)
    dt0 = jnp.exp(jax.random.uniform(ks[9], (DEPTH, SSD_HEADS), f32, math.log(1e-3), math.log(1e-1)))
    dt_bias = dt0 + jnp.log(-jnp.expm1(-dt0))
    a_log = jnp.log(jax.random.uniform(ks[10], (DEPTH, SSD_HEADS), f32, 1.0, 16.0))
    d_skip = 1.0 + 0.1 * jax.random.normal(ks[11], (DEPTH, SSD_HEADS), f32)
    ssd_norm_g = 1.0 + 0.02 * jax.random.normal(ks[12], (DEPTH, SSD_WIDTH), f32)
    b_forget = jax.random.uniform(ks[13], (DEPTH, FOX_HEADS), f32, 2.0, 5.0)
    w_out = MIX_WIDTH ** -0.5 * jax.random.normal(ks[14], (DEPTH, MIX_WIDTH, D_MODEL), f32)
    final_g = 1.0 + 0.02 * jax.random.normal(ks[15], (D_MODEL,), f32)
    return {"x": x, "c": c, "positions": positions, "norm_g": norm_g, "w_ada": w_ada,
            "b_ada": b_ada, "w_in": w_in, "conv_w": conv_w, "conv_b": conv_b,
            "dt_bias": dt_bias, "a_log": a_log, "d_skip": d_skip, "ssd_norm_g": ssd_norm_g,
            "b_forget": b_forget, "w_out": w_out, "final_g": final_g}


def reference(x, c, positions, norm_g, w_ada, b_ada, w_in, conv_w, conv_b,
              dt_bias, a_log, d_skip, ssd_norm_g, b_forget, w_out, final_g):
    for layer in range(DEPTH):
        x = _layer(x, c, positions, norm_g[layer], w_ada[layer], b_ada[layer], w_in[layer],
                   conv_w[layer], conv_b[layer], dt_bias[layer], a_log[layer], d_skip[layer],
                   ssd_norm_g[layer], b_forget[layer], w_out[layer])
    return _rmsnorm(x, final_g)
```

```cpp
#include <hip/hip_runtime.h>
#include <hip/hip_cooperative_groups.h>
#include <cstdio>
#include <cmath>
namespace cg = cooperative_groups;

#define DI __device__ __forceinline__
typedef unsigned short bf16_t;
typedef short bf16x8 __attribute__((ext_vector_type(8)));
typedef float f32x4 __attribute__((ext_vector_type(4)));

constexpr int SEQ = 8192, DM = 1024, NLAYER = 4, ROWS = 32768, HROWS = 16384;
constexpr int NP = 6656;
constexpr int NWIN = 6912;
constexpr int NIN = 6680;
constexpr int C_RQ = 0, C_RK = 512, C_RV = 1024, C_XS = 1536, C_FQ = 3072, C_FK = 3584, C_FV = 4096, C_RG = 4608, C_Z = 5120, C_FG = 6144;
constexpr int NTHR = 512;
constexpr int LDS_BYTES = 147456;
constexpr float LOG2E = 1.4426950408889634f;
constexpr float EPS = 1e-6f;

constexpr size_t WS_PROJ = 0;
constexpr size_t WS_H = WS_PROJ + (size_t)HROWS * NP * 2;
constexpr size_t WS_SSTP = WS_H;
constexpr size_t WS_WIN = WS_H + (size_t)ROWS * DM * 2;
constexpr size_t WS_WOUT = WS_WIN + (size_t)NLAYER * NWIN * 1024 * 2;
constexpr size_t WS_RST = WS_WOUT + (size_t)NLAYER * 1024 * 2048 * 2;
constexpr size_t WS_SST = WS_RST + (size_t)2 * 64 * 4 * 16384 * 4;
constexpr size_t WS_CS = WS_SST + (size_t)2 * 64 * 16 * 8192 * 4;
constexpr size_t WS_TAIL = WS_CS + (size_t)ROWS * 64 * 8;
constexpr size_t WS_MOD = WS_TAIL + (size_t)ROWS * 24 * 4;
constexpr size_t WS_ASUM = WS_MOD + (size_t)NLAYER * 4 * 3072 * 4;
constexpr size_t WS_CTR = WS_ASUM + (size_t)2 * 64 * 16 * 4;
constexpr size_t WS_XC = WS_CTR + 1024;
constexpr size_t WS_BAR = WS_XC + (size_t)HROWS * 1536 * 2;
constexpr size_t WS_KMAX = WS_BAR + 16384;
constexpr size_t WS_END = WS_KMAX + 256;

struct Params {
  const float* x; const float* c; const int* pos; const float* norm_g; const float* w_ada; const float* b_ada;
  const float* w_in; const float* conv_w; const float* conv_b; const float* dt_bias; const float* a_log;
  const float* d_skip; const float* ssd_norm_g; const float* b_forget; const float* w_out; const float* final_g;
  float* out; unsigned char* ws;
};

DI unsigned pk2(float lo, float hi) { unsigned r; asm volatile("v_cvt_pk_bf16_f32 %0, %1, %2" : "=v"(r) : "v"(lo), "v"(hi)); return r; }
DI float bflo(unsigned u) { return __uint_as_float(u << 16); }
DI float bfhi(unsigned u) { return __uint_as_float(u & 0xffff0000u); }
DI float bf2f(bf16_t v) { return __uint_as_float(((unsigned)v) << 16); }
DI bf16_t f2bf(float f) { unsigned u = __float_as_uint(f); u += 0x7fffu + ((u >> 16) & 1u); return (bf16_t)(u >> 16); }
DI void unpack8(uint4 v, float* f) { f[0] = bflo(v.x); f[1] = bfhi(v.x); f[2] = bflo(v.y); f[3] = bfhi(v.y); f[4] = bflo(v.z); f[5] = bfhi(v.z); f[6] = bflo(v.w); f[7] = bfhi(v.w); }
DI uint4 pack8(const float* f) { uint4 r; r.x = pk2(f[0], f[1]); r.y = pk2(f[2], f[3]); r.z = pk2(f[4], f[5]); r.w = pk2(f[6], f[7]); return r; }
DI float silu_f(float x) { return x * __builtin_amdgcn_rcpf(1.0f + __expf(-x)); }
DI float softplus_f(float x) { return fmaxf(x, 0.f) + log1pf(__expf(-fabsf(x))); }
DI float ex2(float x) { return __builtin_amdgcn_exp2f(x); }
DI f32x4 mmaT(bf16x8 a_m, bf16x8 b_n, f32x4 c) { return __builtin_amdgcn_mfma_f32_16x16x32_bf16(b_n, a_m, c, 0, 0, 0); }
DI bf16x8 ldf(const bf16_t* s, int ld, int r0, int k0, int fr, int fq) { return *(const bf16x8*)(s + (r0 + fr) * ld + k0 + fq * 8); }
typedef short v4i16_t __attribute__((ext_vector_type(4)));
#define LDSP __attribute__((address_space(3)))
DI v4i16_t tr_rd(const bf16_t* a) { return __builtin_amdgcn_ds_read_tr16_b64_v4i16((LDSP v4i16_t*)a); }
DI bf16x8 frag_tr(const bf16_t* T, int ld, int k0, int n0, int fr, int fq) {
  const bf16_t* a = T + (k0 + 8 * fq + (fr >> 2)) * ld + n0 + 4 * (fr & 3);
  const v4i16_t lo = tr_rd(a), hi = tr_rd(a + 4 * ld);
  return __builtin_shufflevector(lo, hi, 0, 1, 2, 3, 4, 5, 6, 7);
}
DI float shx(float v, int m, int lane) { return __int_as_float(__builtin_amdgcn_ds_bpermute((lane ^ m) << 2, __float_as_int(v))); }
DI float shup(float v, int off, int lane) { return __int_as_float(__builtin_amdgcn_ds_bpermute((lane - off) << 2, __float_as_int(v))); }
DI bf16x8 mk8(unsigned a, unsigned b, unsigned c, unsigned d) { uint4 v; v.x = a; v.y = b; v.z = c; v.w = d; return __builtin_bit_cast(bf16x8, v); }

DI unsigned char* ows(const Params& p) { return p.ws; }
DI size_t wimg_off(int n, int k, int K) {
  const int r = n & 127, c = k & 31, ob = (r & 15) * 64 + c * 2;
  return ((size_t)(n >> 7) * (K >> 5) + (k >> 5)) * 4096 + (((r >> 4) * 1024 + (ob ^ (((ob >> 9) & 1) << 5))) >> 1);
}
DI void transpose_tile(const float* src, int src_ld, int k0, int sc0, bf16_t* dst, int dst_ld, int n0, float* sT  , int tid) {
  float4 v[8];
#pragma unroll
  for (int i = 0; i < 8; ++i) v[i] = *(const float4*)(src + (size_t)(k0 + (tid >> 6) + 8 * i) * src_ld + sc0 + (tid & 63) * 4);
#pragma unroll
  for (int i = 0; i < 8; ++i) { float* q = sT + ((tid >> 6) + 8 * i) * 257 + (tid & 63) * 4; q[0] = v[i].x; q[1] = v[i].y; q[2] = v[i].z; q[3] = v[i].w; }
  __syncthreads();
  {
    const int n = tid >> 1, kh = (tid & 1) * 32;
#pragma unroll
    for (int q = 0; q < 4; ++q) {
      const float* c = sT + (kh + 8 * q) * 257 + n;
      uint4 w;
      w.x = pk2(c[0], c[257]); w.y = pk2(c[2 * 257], c[3 * 257]); w.z = pk2(c[4 * 257], c[5 * 257]); w.w = pk2(c[6 * 257], c[7 * 257]);
      *(uint4*)(dst + wimg_off(n0 + n, k0 + kh + 8 * q, dst_ld)) = w;
    }
  }
  __syncthreads();
}

DI int win_src_col(int d) {
  if (d < 1536) return d;
  if (d < 3072) return d + 512;
  if (d < 4608) return d + 1552;
  if (d < 5120) return d - 3072;
  if (d < 6144) return d - 1520;
  return d + 16;
}

DI void phase0(const Params& p, unsigned char* shm, int tid) {
  unsigned char* wsb = ows(p);
  float* sT = (float*)shm;
  float* ssc = (float*)(shm + 69632);
  float* red = (float*)(shm + 69632 + 16384);
  bf16_t* wtin = (bf16_t*)(wsb + WS_WIN);
  bf16_t* wtout = (bf16_t*)(wsb + WS_WOUT);
  float* mod = (float*)(wsb + WS_MOD);
  for (int i = tid; i < 4096; i += NTHR) ssc[i] = silu_f(p.c[i]);
  __syncthreads();
  const int n_mod = 192, n_win = NLAYER * 16 * 26, n_wout = NLAYER * 32 * 4;
  for (int it = blockIdx.x; it < n_mod + n_win + n_wout; it += gridDim.x) {
    if (it < n_mod) {
      const int l = it / 48, cgp = it % 48, kc = tid >> 6, col = tid & 63;
      float a0 = 0.f, a1 = 0.f, a2 = 0.f, a3 = 0.f;
      const float* wp = p.w_ada + ((size_t)l * 1024 + kc * 128) * 3072 + cgp * 64 + col;
#pragma unroll 8
      for (int k = 0; k < 128; ++k) {
        const float w = wp[(size_t)k * 3072]; const int kk = kc * 128 + k;
        a0 += ssc[kk] * w; a1 += ssc[1024 + kk] * w; a2 += ssc[2048 + kk] * w; a3 += ssc[3072 + kk] * w;
      }
      red[(kc * 4 + 0) * 64 + col] = a0; red[(kc * 4 + 1) * 64 + col] = a1; red[(kc * 4 + 2) * 64 + col] = a2; red[(kc * 4 + 3) * 64 + col] = a3;
      __syncthreads();
      if (tid < 256) {
        const int b = tid >> 6, cc = tid & 63; float s = 0.f;
#pragma unroll
        for (int q = 0; q < 8; ++q) s += red[(q * 4 + b) * 64 + cc];
        mod[(size_t)(l * 4 + b) * 3072 + cgp * 64 + cc] = s + p.b_ada[l * 3072 + cgp * 64 + cc];
      }
      __syncthreads();
    } else if (it < n_mod + n_win) {
      const int j = it - n_mod, l = j / (16 * 26), r = j % (16 * 26), kt = r / 26, nt = r % 26;
      transpose_tile(p.w_in + (size_t)l * 1024 * NIN, NIN, kt * 64, win_src_col(nt * 256), wtin + (size_t)l * NWIN * 1024, 1024, nt * 256, sT, tid);
    } else {
      const int j = it - n_mod - n_win, l = j / 128, r = j % 128, kt = r / 4, nt = r % 4;
      transpose_tile(p.w_out + (size_t)l * 2048 * 1024, 1024, kt * 64, nt * 256, wtout + (size_t)l * 1024 * 2048, 2048, nt * 256, sT, tid);
    }
  }
  const int gtid = blockIdx.x * NTHR + tid, gn = gridDim.x * NTHR;
  for (int i = gtid; i < NLAYER * 256 * 1024; i += gn) {
    const int l = i / (256 * 1024), r = (i / 1024) % 256, k = i % 1024;
    float v = 0.f;
    if (r < 16) v = p.w_in[((size_t)l * 1024 + k) * NIN + 3584 + r];
    else if (r < 24) v = p.w_in[((size_t)l * 1024 + k) * NIN + 6672 + (r - 16)];
    wtin[(size_t)l * NWIN * 1024 + wimg_off(6656 + r, k, 1024)] = f2bf(v);
  }
  float2* cs = (float2*)(wsb + WS_CS);
  for (int i = gtid; i < ROWS * 64; i += gn) {
    const int row = i >> 6, fi = i & 63;
    const float ang = (float)p.pos[row] * (float)exp2(-(double)fi * (13.287712379549449 / 64.0));
    const double a = (double)ang;
    const double kq = rint(a * 0.6366197723675814);
    const float r = (float)fma(-kq, 1.5707963267948966, a);
    const float r2 = r * r;
    const float sn = r + r * r2 * (-1.6666667e-1f + r2 * (8.3333333e-3f + r2 * (-1.9841270e-4f + r2 * 2.7557319e-6f)));
    const float cn = 1.0f + r2 * (-0.5f + r2 * (4.1666667e-2f + r2 * (-1.3888889e-3f + r2 * (2.4801587e-5f + r2 * -2.7557319e-7f))));
    const int q = ((int)kq) & 3;
    float co, si;
    if (q == 0) { co = cn; si = sn; } else if (q == 1) { co = -sn; si = cn; } else if (q == 2) { co = -cn; si = -sn; } else { co = sn; si = -cn; }
    cs[i] = make_float2(co, si);
  }
  int* ctr = (int*)(wsb + WS_CTR);
  for (int i = gtid; i < 256; i += gn) ctr[i] = 0;
  unsigned* barw = (unsigned*)(wsb + WS_BAR);
  for (int i = gtid; i < 3456; i += gn) barw[i] = 0u;
}

DI void norm_rows(const Params& p, int layer, int row0, int nrows, int wstart, int wstride, int tid) {
  unsigned char* wsb = ows(p);
  const float* xin = (layer == 0) ? p.x : p.out;
  const int wid = tid >> 6, lane = tid & 63;
  bf16_t* h = (bf16_t*)(wsb + WS_H);
  const float* modb = (const float*)(wsb + WS_MOD);
  for (int rowa = row0 + wstart + wid; rowa < row0 + nrows; rowa += 2 * wstride) {
    const int rowb = (rowa + wstride < row0 + nrows) ? rowa + wstride : rowa;
    float4 va[4], vb[4]; float sa = 0.f, sb = 0.f;
#pragma unroll
    for (int i = 0; i < 4; ++i) { va[i] = *(const float4*)(xin + (size_t)rowa * DM + i * 256 + lane * 4); vb[i] = *(const float4*)(xin + (size_t)rowb * DM + i * 256 + lane * 4); }
#pragma unroll
    for (int i = 0; i < 4; ++i) { sa += va[i].x * va[i].x + va[i].y * va[i].y + va[i].z * va[i].z + va[i].w * va[i].w; sb += vb[i].x * vb[i].x + vb[i].y * vb[i].y + vb[i].z * vb[i].z + vb[i].w * vb[i].w; }
#pragma unroll
    for (int o = 32; o >= 1; o >>= 1) { sa += shx(sa, o, lane); sb += shx(sb, o, lane); }
#pragma unroll
    for (int rr = 0; rr < 2; ++rr) {
      const int row = rr ? rowb : rowa; const float rinv = rsqrtf((rr ? sb : sa) * (1.0f / 1024.0f) + EPS);
      if (layer < NLAYER) {
        const int b = row >> 13; const float* md = modb + (size_t)(layer * 4 + b) * 3072; const float* g = p.norm_g + layer * 1024;
#pragma unroll
        for (int i = 0; i < 4; ++i) {
          const float4 x4 = rr ? vb[i] : va[i];
          const int e = i * 256 + lane * 4;
          const float4 g4 = *(const float4*)(g + e), sh = *(const float4*)(md + e), sc = *(const float4*)(md + 1024 + e);
          uint2 w;
          w.x = pk2(x4.x * rinv * g4.x * (1.f + sc.x) + sh.x, x4.y * rinv * g4.y * (1.f + sc.y) + sh.y);
          w.y = pk2(x4.z * rinv * g4.z * (1.f + sc.z) + sh.z, x4.w * rinv * g4.w * (1.f + sc.w) + sh.w);
          *(uint2*)(h + wimg_off(row, e, DM)) = w;
        }
      } else {
#pragma unroll
        for (int i = 0; i < 4; ++i) {
          const float4 x4 = rr ? vb[i] : va[i];
          const int e = i * 256 + lane * 4; const float4 g4 = *(const float4*)(p.final_g + e);
          float4 o4; o4.x = x4.x * rinv * g4.x; o4.y = x4.y * rinv * g4.y; o4.z = x4.z * rinv * g4.z; o4.w = x4.w * rinv * g4.w;
          *(float4*)(p.out + (size_t)row * DM + e) = o4;
        }
      }
    }
  }
}
DI void norm_phase(const Params& p, int layer, int tid) { norm_rows(p, layer, 0, ROWS, blockIdx.x * 8, gridDim.x * 8, tid); }
DI void norm_unit(const Params& p, int layer, int half, int nu, int tid) { norm_rows(p, layer, half * HROWS + nu * 64, 64, 0, 8, tid); }
constexpr int BM = 256, BK = 64, HALF = 128, HT = HALF * BK;
DI int lds_byte(int r, int c) { int st = (r >> 4) * 2 + (c >> 5), rr = r & 15, cc = c & 31, ob = rr * 64 + cc * 2; return st * 1024 + (ob ^ (((ob >> 9) & 1) << 5)); }
DI void stage_rc(int b, int& R, int& C) { int st = b / 1024, sb = b % 1024, swz = sb ^ (((sb >> 9) & 1) << 5); R = (st >> 1) * 16 + swz / 64; C = (st & 1) * 32 + (swz % 64) / 2; }
struct Unit { int pm, pn; };
DI bool unit_next(int i, int G, int c, int nM, int nN, Unit& u) {
  const int nwg = nM * nN; const long Lx = (long)i * G + c; if (Lx >= nwg) return false;
  int wgid = (int)Lx; { const int q = nwg / 8, r = nwg % 8, xcd = wgid % 8, off = wgid / 8; wgid = (xcd < r ? xcd * (q + 1) : r * (q + 1) + (xcd - r) * q) + off; }
  const int nig = 8 * nN, gid = wgid / nig, fm = gid * 8, gsz = (nM - fm) < 8 ? (nM - fm) : 8;
  u.pm = fm + ((wgid % nig) % gsz); u.pn = (wgid % nig) / gsz; return true;
}

template <int MODE>
DI void gemm_phase(const Params& p, int layer, int hf, unsigned char* shmc, int tid) {
  unsigned char* wsb = ows(p);
  const bf16_t* A; const bf16_t* Bt; int lda, ldb, K, nM, nN;
  if (MODE == 0) { A = (const bf16_t*)(wsb + WS_H) + (size_t)hf * HROWS * DM; lda = DM; Bt = (const bf16_t*)(wsb + WS_WIN) + (size_t)layer * NWIN * 1024; ldb = 1024; K = 1024; nM = HROWS / BM; nN = NWIN / BM; }
  else { A = (const bf16_t*)(wsb + WS_PROJ) + C_RG; lda = NP; Bt = (const bf16_t*)(wsb + WS_WOUT) + (size_t)layer * 1024 * 2048; ldb = 2048; K = 2048; nM = HROWS / BM; nN = DM / BM; }
#define WAIT_V(n) asm volatile("s_waitcnt vmcnt(" #n ")" ::: "memory")
#define BAR __builtin_amdgcn_s_barrier()
  const int wid = tid >> 6, lane = tid & 63, wr = wid >> 2, wc = wid & 3, fr = lane & 15, fq = lane >> 4;
  constexpr int BK2 = 32, NST = 4;
  const int nt = K / BK2;
  int la0, lb0;
  { const int ob = fr * 64 + fq * 16, sw = ob ^ (((ob >> 9) & 1) << 5); la0 = (wr * 4) * 1024 + sw; lb0 = (wc * 2) * 1024 + sw; }
  Unit u, un;
  bool have = unit_next(0, gridDim.x, blockIdx.x, nM, nN, u), pre = false;
  for (int ui = 0; have; ++ui) {
    const bool have_n = unit_next(ui + 1, gridDim.x, blockIdx.x, nM, nN, un);
    const int brow = u.pm * BM, bcol = u.pn * BM;
    f32x4 acc[2][2][4][2];
#pragma unroll
    for (int a = 0; a < 2; ++a)
#pragma unroll
      for (int b = 0; b < 2; ++b)
#pragma unroll
        for (int m = 0; m < 4; ++m)
#pragma unroll
          for (int n = 0; n < 2; ++n) acc[a][b][m][n] = (f32x4){0.f, 0.f, 0.f, 0.f};
    const bf16_t* gA = (MODE == 0) ? A + (size_t)(brow >> 7) * nt * 4096 : A + (size_t)brow * lda; const bf16_t* gB = Bt + (size_t)(bcol >> 7) * nt * 4096;
#define STAGE_ALL(st, kt) do { int _t = tid; asm volatile("" : "+v"(_t)); unsigned char* _s = shmc + (st) * 32768 + _t * 16; \
      const int _sb = (_t & 63) * 16, _sw = _sb ^ (((_sb >> 9) & 1) << 5), _r = (_t >> 6) * 16 + (_sw >> 6), _c = (_sw & 63) >> 1; \
      const int _oa = _r * lda + _c + (kt) * BK2; \
      _Pragma("unroll") for (int _h = 0; _h < 2; ++_h) { \
        __builtin_amdgcn_global_load_lds((const unsigned*)((MODE == 0) ? gA + ((size_t)_h * nt + (kt)) * 4096 + _t * 8 : gA + (size_t)_h * HALF * lda + _oa), (unsigned*)(_s + _h * 8192), 16, 0, 0); \
        __builtin_amdgcn_global_load_lds((const unsigned*)(gB + ((size_t)_h * nt + (kt)) * 4096 + _t * 8), (unsigned*)(_s + 16384 + _h * 8192), 16, 0, 0); } } while (0)
    if (!pre) { STAGE_ALL(0, 0); STAGE_ALL(1, 1); }
    STAGE_ALL(2, 2);
    for (int kt = 0; kt < nt; ++kt) {
      const int rem = nt - 1 - kt;
      if (rem >= 2) WAIT_V(8); else if (rem == 1) WAIT_V(4); else WAIT_V(0);
      BAR;
      const unsigned char* sb = shmc + (kt & 3) * 32768;
#define LDA_(dst, ai) _Pragma("unroll") for (int m = 0; m < 4; ++m) dst[m] = *(const bf16x8*)(sb + (ai) * 8192 + la0 + m * 1024)
#define LDB_(dst) _Pragma("unroll") for (int bj = 0; bj < 2; ++bj) _Pragma("unroll") for (int n = 0; n < 2; ++n) dst[bj][n] = *(const bf16x8*)(sb + 16384 + bj * 8192 + lb0 + n * 1024)
#define MMA_(ai, bf_, af_) _Pragma("unroll") for (int bj = 0; bj < 2; ++bj) _Pragma("unroll") for (int m = 0; m < 4; ++m) _Pragma("unroll") for (int n = 0; n < 2; ++n) \
        acc[ai][bj][m][n] = __builtin_amdgcn_mfma_f32_16x16x32_bf16(bf_[bj][n], af_[m], acc[ai][bj][m][n], 0, 0, 0)
      {
        bf16x8 b0[2][2], a0[4], a1[4];
        LDB_(b0); LDA_(a0, 0);
        __builtin_amdgcn_sched_barrier(0);
        LDA_(a1, 1); MMA_(0, b0, a0);
        __builtin_amdgcn_sched_barrier(0);
        if (kt + 3 < nt) STAGE_ALL((kt + 3) & 3, kt + 3);
        __builtin_amdgcn_sched_barrier(0);
        MMA_(1, b0, a1);
      }
#undef LDA_
#undef LDB_
#undef MMA_
    }
    __syncthreads();
    pre = false;
    if (pre) {
      gA = A + (size_t)((un.pm * BM) >> 7) * nt * 4096; gB = Bt + (size_t)((un.pn * BM) >> 7) * nt * 4096;
      STAGE_ALL(0, 0); STAGE_ALL(1, 1);
    }
    const int row_b = brow + wr * 64 + fr, col_b = bcol + wc * 32 + fq * 4;
    if (MODE == 0) {
      if (u.pn < 26) {
        bf16_t* proj = (bf16_t*)(wsb + WS_PROJ);
        unsigned char* es = shmc + 65536;
#pragma unroll
        for (int ai = 0; ai < 2; ++ai) {
#pragma unroll
          for (int m = 0; m < 4; ++m) {
            unsigned char* rp = es + (wr * 64 + m * 16 + fr) * 528 + (wc * 32 + fq * 4) * 2;
#pragma unroll
            for (int bj = 0; bj < 2; ++bj)
#pragma unroll
              for (int n = 0; n < 2; ++n) { const f32x4 v = acc[ai][bj][m][n]; uint2 w; w.x = pk2(v[0], v[1]); w.y = pk2(v[2], v[3]); *(uint2*)(rp + (bj * HALF + n * 16) * 2) = w; }
          }
          __syncthreads();
          {
            const int r0 = tid >> 5, ch = tid & 31;
#pragma unroll
            for (int i = 0; i < 8; ++i) {
              const int row = r0 + 16 * i;
              { typedef unsigned u32x4_t __attribute__((ext_vector_type(4))); const u32x4_t v_ = *(const u32x4_t*)(es + row * 528 + ch * 16); __builtin_nontemporal_store(v_, (u32x4_t*)(proj + (size_t)(brow + ai * HALF + row) * NP + bcol + ch * 8)); }
            }
          }
          __syncthreads();
        }
      } else {
        float* tail = (float*)(wsb + WS_TAIL);
        float* sT = (float*)shmc;
        if (wc == 0) {
#pragma unroll
          for (int ai = 0; ai < 2; ++ai)
#pragma unroll
            for (int m = 0; m < 4; ++m)
#pragma unroll
              for (int n = 0; n < 2; ++n) *(f32x4*)(sT + (ai * HALF + wr * 64 + m * 16 + fr) * 36 + n * 16 + fq * 4) = acc[ai][0][m][n];
        }
        __syncthreads();
        float* tp = tail + (size_t)(hf * HROWS + brow) * 24;
#pragma unroll 1
        for (int idx = tid; idx < 256 * 24; idx += NTHR) {
          const int row = idx / 24, col = idx - row * 24;
          const float v = sT[row * 36 + col];
          float r;
          if (col < 16) r = softplus_f(v + p.dt_bias[layer * 16 + col]);
          else r = -softplus_f(-(v + p.b_forget[layer * 8 + col - 16]));
          tp[idx] = r;
        }
        __syncthreads();
      }
    } else {
      const float* xin = (layer == 0) ? p.x : p.out;
      const float* modb = (const float*)(wsb + WS_MOD);
#pragma unroll
      for (int ai = 0; ai < 2; ++ai) {
#pragma unroll
        for (int m = 0; m < 4; ++m) {
          unsigned char* rp = shmc + (wr * 64 + m * 16 + fr) * 1040 + (wc * 32 + fq * 4) * 4;
#pragma unroll
          for (int bj = 0; bj < 2; ++bj)
#pragma unroll
            for (int n = 0; n < 2; ++n) *(f32x4*)(rp + (bj * HALF + n * 16) * 4) = acc[ai][bj][m][n];
        }
        __syncthreads();
        {
          const int r0 = tid >> 6, ch = tid & 63;
          const int growb = hf * HROWS + brow + ai * HALF;
          const float* gate = modb + (size_t)(layer * 4 + (growb >> 13)) * 3072 + 2048 + bcol + ch * 4;
          const float4 g = *(const float4*)gate;
#pragma unroll 4
          for (int i = 0; i < 16; ++i) {
            const int row = r0 + 8 * i;
            const float4 v = *(const float4*)(shmc + row * 1040 + ch * 16);
            const size_t off = (size_t)(growb + row) * DM + bcol + ch * 4;
            const f32x4 xo = __builtin_nontemporal_load((const f32x4*)(xin + off));
            f32x4 o; o[0] = xo[0] + g.x * v.x; o[1] = xo[1] + g.y * v.y; o[2] = xo[2] + g.z * v.z; o[3] = xo[3] + g.w * v.w;
            __builtin_nontemporal_store(o, (f32x4*)(p.out + off));
          }
        }
        __syncthreads();
      }
    }
    u = un; have = have_n;
  }
#undef STAGE_ALL
#undef WAIT_V
#undef BAR
}

DI void conv8(const bf16_t* projb, int t, int ch0, const float* cw, const float* cb, float* o) {
  const float4 b0 = *(const float4*)(cb + ch0), b1 = *(const float4*)(cb + ch0 + 4);
  float a[8] = {b0.x, b0.y, b0.z, b0.w, b1.x, b1.y, b1.z, b1.w};
#pragma unroll
  for (int i = 0; i < 4; ++i) {
    const int tt = t - 3 + i;
    if (tt >= 0) {
      const uint4 raw = *(const uint4*)(projb + (size_t)tt * NP + C_XS + ch0);
      const float4 w0 = *(const float4*)(cw + i * 1536 + ch0), w1 = *(const float4*)(cw + i * 1536 + ch0 + 4);
      float u[8]; unpack8(raw, u);
      a[0] += w0.x * u[0]; a[1] += w0.y * u[1]; a[2] += w0.z * u[2]; a[3] += w0.w * u[3];
      a[4] += w1.x * u[4]; a[5] += w1.y * u[5]; a[6] += w1.z * u[6]; a[7] += w1.w * u[7];
    }
  }
#pragma unroll
  for (int e = 0; e < 8; ++e) o[e] = silu_f(a[e]);
}

constexpr int LD = 136;

DI void wave_cumsum128(float a0, float a1, int lane, float& c0, float& c1, float& last) {
  const float s1 = a0 + a1; float v = s1;
#pragma unroll
  for (int off = 1; off < 64; off <<= 1) { const float t = shup(v, off, lane); if (lane >= off) v += t; }
  const float ex = v - s1; c0 = ex + a0; c1 = ex + s1; last = __int_as_float(__builtin_amdgcn_readlane(__float_as_int(v), 63));
}

DI void ret_local_unit(const Params& p, int hf, int bl, int c, int hd, unsigned char* shm, int tid) {
  unsigned char* wsb = ows(p);
  bf16_t* sK = (bf16_t*)shm; bf16_t* sV = sK + 128 * LD;
  const bf16_t* projb = (const bf16_t*)(wsb + WS_PROJ) + (size_t)bl * SEQ * NP;
  const float2* cs = (const float2*)(wsb + WS_CS) + (size_t)((hf * 2 + bl) * SEQ + c * 128) * 64;
  const float lg = logf(1.0f - ex2(-5.0f - (float)hd));
#pragma unroll
  for (int it = 0; it < 2; ++it) {
    const int idx = tid + it * NTHR, j = idx >> 3, dg = idx & 7;
    const bf16_t* base = projb + (size_t)(c * 128 + j) * NP;
    float k1[8], k2[8]; unpack8(*(const uint4*)(base + C_RK + hd * 128 + dg * 8), k1); unpack8(*(const uint4*)(base + C_RK + hd * 128 + 64 + dg * 8), k2);
    const float w = __expf(lg * (float)(127 - j)) * 0.08838834764831845f;
    float o1[8], o2[8];
#pragma unroll
    for (int e = 0; e < 8; ++e) {
      const float2 t = cs[j * 64 + dg * 8 + e];
      o1[e] = (k1[e] * t.x - k2[e] * t.y) * w; o2[e] = (k1[e] * t.y + k2[e] * t.x) * w;
    }
    *(uint4*)(sK + j * LD + dg * 8) = pack8(o1); *(uint4*)(sK + j * LD + 64 + dg * 8) = pack8(o2);
    *(uint4*)(sV + j * LD + dg * 16) = *(const uint4*)(base + C_RV + hd * 128 + dg * 16);
    *(uint4*)(sV + j * LD + dg * 16 + 8) = *(const uint4*)(base + C_RV + hd * 128 + dg * 16 + 8);
  }
  __syncthreads();
  const int wid = tid >> 6, lane = tid & 63, fr = lane & 15, fq = lane >> 4;
  f32x4 acc[8];
#pragma unroll
  for (int n = 0; n < 8; ++n) acc[n] = (f32x4){0.f, 0.f, 0.f, 0.f};
#pragma unroll
  for (int ks = 0; ks < 4; ++ks) {
    const bf16x8 a = frag_tr(sV, LD, 32 * ks, 16 * wid, fr, fq);
#pragma unroll
    for (int n = 0; n < 8; ++n) acc[n] = mmaT(a, frag_tr(sK, LD, 32 * ks, 16 * n, fr, fq), acc[n]);
  }
  bf16_t* st = (bf16_t*)(wsb + WS_RST) + (size_t)((bl * 64 + c) * 4 + hd) * 16384;
#pragma unroll
  for (int n = 0; n < 8; ++n) { uint2 w; w.x = pk2(acc[n][0], acc[n][1]); w.y = pk2(acc[n][2], acc[n][3]); *(uint2*)(st + (16 * wid + fr) * 128 + 16 * n + 4 * fq) = w; }
  __syncthreads();
}

#define CONV_RUN8(projb, t0, ch0, cw, cb, EMIT) do { \
    float w_[4][8], b_[8], win_[3][8]; \
    { const float4 x0 = *(const float4*)((cb) + (ch0)), x1 = *(const float4*)((cb) + (ch0) + 4); b_[0] = x0.x; b_[1] = x0.y; b_[2] = x0.z; b_[3] = x0.w; b_[4] = x1.x; b_[5] = x1.y; b_[6] = x1.z; b_[7] = x1.w; } \
    _Pragma("unroll") for (int i_ = 0; i_ < 4; ++i_) { const float4 x0 = *(const float4*)((cw) + i_ * 1536 + (ch0)), x1 = *(const float4*)((cw) + i_ * 1536 + (ch0) + 4); \
      w_[i_][0] = x0.x; w_[i_][1] = x0.y; w_[i_][2] = x0.z; w_[i_][3] = x0.w; w_[i_][4] = x1.x; w_[i_][5] = x1.y; w_[i_][6] = x1.z; w_[i_][7] = x1.w; } \
    uint4 raw_[11]; \
    _Pragma("unroll") for (int i_ = 0; i_ < 11; ++i_) { const int tt_ = (t0) - 3 + i_; raw_[i_] = (tt_ >= 0) ? *(const uint4*)((projb) + (size_t)tt_ * NP + C_XS + (ch0)) : make_uint4(0u, 0u, 0u, 0u); } \
    _Pragma("unroll") for (int i_ = 0; i_ < 3; ++i_) unpack8(raw_[i_], win_[i_]); \
    _Pragma("unroll") for (int r_ = 0; r_ < 8; ++r_) { float cur_[8], o_[8]; unpack8(raw_[3 + r_], cur_); \
      _Pragma("unroll") for (int e_ = 0; e_ < 8; ++e_) { o_[e_] = silu_f(b_[e_] + w_[0][e_] * win_[0][e_] + w_[1][e_] * win_[1][e_] + w_[2][e_] * win_[2][e_] + w_[3][e_] * cur_[e_]); \
        win_[0][e_] = win_[1][e_]; win_[1][e_] = win_[2][e_]; win_[2][e_] = cur_[e_]; } \
      EMIT(r_, o_); } } while (0)

DI void ssd_local_unit(const Params& p, int layer, int hf, int bl, int c, int g, unsigned char* shm, int tid) {
  unsigned char* wsb = ows(p);
  constexpr int LX = 264;
  bf16_t* sB = (bf16_t*)shm; bf16_t* sX = sB + 128 * LD;
  float* sW = (float*)(sX + 128 * LX);
  const bf16_t* projb = (const bf16_t*)(wsb + WS_PROJ) + (size_t)bl * SEQ * NP;
  bf16_t* xcb = (bf16_t*)(wsb + WS_XC) + (size_t)(bl * SEQ) * 1536;
  const float* tail = (const float*)(wsb + WS_TAIL) + (size_t)((hf * 2 + bl) * SEQ + c * 128) * 24;
  const float* cw = p.conv_w + (size_t)layer * 4 * 1536; const float* cb = p.conv_b + layer * 1536;
  const int wid = tid >> 6, lane = tid & 63, fr = lane & 15, fq = lane >> 4;
  {
    const int h = g * 8 + wid; const float Ah = -__expf(p.a_log[layer * 16 + h]);
    const float d0 = tail[(2 * lane) * 24 + h], d1 = tail[(2 * lane + 1) * 24 + h];
    float c0, c1, last; wave_cumsum128(d0 * Ah, d1 * Ah, lane, c0, c1, last);
    sW[wid * 128 + 2 * lane] = d0 * __expf(last - c0); sW[wid * 128 + 2 * lane + 1] = d1 * __expf(last - c1);
    if (lane == 0) ((float*)(wsb + WS_ASUM))[(bl * 64 + c) * 16 + h] = last;
  }
  const int cgi = tid & 31, trg = tid >> 5, t0 = c * 128 + trg * 8;
  {
    const int ch0 = (cgi < 16) ? (1024 + g * 128 + cgi * 8) : (1280 + g * 128 + (cgi - 16) * 8);
#define EMIT_BC(r, o) do { const uint4 pk_ = pack8(o); *(uint4*)(xcb + (size_t)(t0 + (r)) * 1536 + ch0) = pk_; if (cgi < 16) *(uint4*)(sB + (trg * 8 + (r)) * LD + cgi * 8) = pk_; } while (0)
    CONV_RUN8(projb, t0, ch0, cw, cb, EMIT_BC);
#undef EMIT_BC
  }
  __syncthreads();
  for (int hb = 0; hb < 2; ++hb) {
    {
      const int hq = cgi >> 3, ch0 = (g * 8 + hb * 4) * 64 + cgi * 8;
#define EMIT_X(r, o) do { *(uint4*)(xcb + (size_t)(t0 + (r)) * 1536 + ch0) = pack8(o); const float w__ = sW[(hb * 4 + hq) * 128 + trg * 8 + (r)]; \
        float s__[8]; _Pragma("unroll") for (int e__ = 0; e__ < 8; ++e__) s__[e__] = (o)[e__] * w__; *(uint4*)(sX + (trg * 8 + (r)) * LX + cgi * 8) = pack8(s__); } while (0)
      CONV_RUN8(projb, t0, ch0, cw, cb, EMIT_X);
#undef EMIT_X
    }
    __syncthreads();
    const int hq = wid >> 1, nh = wid & 1;
    f32x4 acc[4][4];
#pragma unroll
    for (int m = 0; m < 4; ++m)
#pragma unroll
      for (int n = 0; n < 4; ++n) acc[m][n] = (f32x4){0.f, 0.f, 0.f, 0.f};
#pragma unroll
    for (int ks = 0; ks < 4; ++ks) {
      bf16x8 bfr[4];
#pragma unroll
      for (int n = 0; n < 4; ++n) bfr[n] = frag_tr(sB, LD, 32 * ks, nh * 64 + 16 * n, fr, fq);
#pragma unroll
      for (int m = 0; m < 4; ++m) {
        const bf16x8 a = frag_tr(sX, LX, 32 * ks, hq * 64 + 16 * m, fr, fq);
#pragma unroll
        for (int n = 0; n < 4; ++n) acc[m][n] = mmaT(a, bfr[n], acc[m][n]);
      }
    }
    float* st = (float*)(wsb + WS_SST) + (size_t)((bl * 64 + c) * 16 + g * 8 + hb * 4 + hq) * 8192;
#pragma unroll
    for (int m = 0; m < 4; ++m)
#pragma unroll
      for (int n = 0; n < 4; ++n) *(f32x4*)(st + (16 * m + fr) * 128 + nh * 64 + 16 * n + 4 * fq) = acc[m][n];
    __syncthreads();
  }
}

DI void fox_cumsum_unit(const Params& p, int hf, int bl, int fh, unsigned char* shm, int tid) {
  unsigned char* wsb = ows(p);
  float* sWv = (float*)shm;
  float* base = (float*)(wsb + WS_TAIL) + (size_t)((hf * 2 + bl) * SEQ) * 24 + 16 + fh;
  const int wid = tid >> 6, lane = tid & 63;
  float v[16];
#pragma unroll
  for (int e = 0; e < 16; ++e) v[e] = base[(size_t)(tid * 16 + e) * 24];
#pragma unroll
  for (int e = 1; e < 16; ++e) v[e] += v[e - 1];
  const float tot = v[15]; float inc = tot;
#pragma unroll
  for (int off = 1; off < 64; off <<= 1) { const float t = shup(inc, off, lane); if (lane >= off) inc += t; }
  if (lane == 63) sWv[wid] = inc;
  __syncthreads();
  float woff = 0.f;
  for (int i = 0; i < wid; ++i) woff += sWv[i];
  const float ex = woff + inc - tot;
#pragma unroll
  for (int e = 0; e < 16; ++e) base[(size_t)(tid * 16 + e) * 24] = v[e] + ex;
  const bf16_t* kb = (const bf16_t*)(wsb + WS_PROJ) + (size_t)(bl * SEQ + tid * 16) * NP + C_FK + fh * 64;
  float kmx = 0.f;
#pragma unroll 4
  for (int e = 0; e < 16; ++e) {
    float ssum = 0.f;
#pragma unroll
    for (int q = 0; q < 8; ++q) { float f[8]; unpack8(*(const uint4*)(kb + (size_t)e * NP + q * 8), f);
#pragma unroll
      for (int z = 0; z < 8; ++z) ssum += f[z] * f[z]; }
    kmx = fmaxf(kmx, ssum);
  }
#pragma unroll
  for (int o = 32; o >= 1; o >>= 1) kmx = fmaxf(kmx, shx(kmx, o, lane));
  __syncthreads();
  if (lane == 0) sWv[16 + wid] = kmx;
  __syncthreads();
  if (tid == 0) { float m = 0.f; for (int i = 0; i < 8; ++i) m = fmaxf(m, sWv[16 + i]); ((float*)(wsb + WS_KMAX))[bl * 8 + fh] = m; }
  __syncthreads();
}

DI void scan_unit(const Params& p, int hf, int su, int tid) {
  unsigned char* wsb = ows(p);
  const int gtid = su * NTHR + tid, gn = 1 << 30;
  bf16_t* rst = (bf16_t*)(wsb + WS_RST); float* sst = (float*)(wsb + WS_SST); const float* asum = (const float*)(wsb + WS_ASUM);
  const int n_r = 2 * 4 * 4096, n_s = 2 * 16 * 2048;
  for (int i = gtid; i < n_r + n_s; i += gn) {
    if (i < n_r) {
      float S0 = 0.f, S1 = 0.f, S2 = 0.f, S3 = 0.f;
      const int bl = i / 16384, hd = (i / 4096) & 3, e = (i & 4095) * 4;
      const float dc = __expf(logf(1.0f - ex2(-5.0f - (float)hd)) * 128.0f);
      bf16_t* ptr = rst + (size_t)(bl * 64 * 4 + hd) * 16384 + e;
#pragma unroll 16
      for (int c = 0; c < 64; ++c) {
        uint2* q = (uint2*)(ptr + (size_t)c * 4 * 16384); const uint2 v = *q;
        uint2 w; w.x = pk2(S0, S1); w.y = pk2(S2, S3); *q = w;
        S0 = S0 * dc + bflo(v.x); S1 = S1 * dc + bfhi(v.x); S2 = S2 * dc + bflo(v.y); S3 = S3 * dc + bfhi(v.y);
      }
    } else {
      const int k = i - n_r, bl = k / 32768, h = (k / 2048) & 15, e = (k & 2047) * 4;
      float S0 = 0.f, S1 = 0.f, S2 = 0.f, S3 = 0.f;
      const float* ptr = sst + (size_t)(bl * 64 * 16 + h) * 8192 + e;
      bf16_t* pp = (bf16_t*)(wsb + WS_SSTP + (size_t)hf * HROWS * DM * 2) + (size_t)(bl * 64 * 16 + h) * 8192 + e;
#pragma unroll 16
      for (int c = 0; c < 64; ++c) {
        const float4 lo = *(const float4*)(ptr + (size_t)c * 16 * 8192);
        uint2 w; w.x = pk2(S0, S1); w.y = pk2(S2, S3); *(uint2*)(pp + (size_t)c * 16 * 8192) = w;
        const float dc = __expf(asum[(bl * 64 + c) * 16 + h]);
        S0 = S0 * dc + lo.x; S1 = S1 * dc + lo.y; S2 = S2 * dc + lo.z; S3 = S3 * dc + lo.w;
      }
    }
  }
}

DI void ret_out_unit(const Params& p, int hf, int bl, int c, int hd, unsigned char* shm, int tid, bool dry = false) {
  unsigned char* wsb = ows(p);
  bf16_t* sQ = (bf16_t*)shm; bf16_t* sK = sQ + 128 * LD; bf16_t* sVt = sK + 128 * LD; bf16_t* sS = sVt + 128 * LD;
  bf16_t* projb = (bf16_t*)(wsb + WS_PROJ) + (size_t)bl * SEQ * NP;
  const float2* cs = (const float2*)(wsb + WS_CS) + (size_t)((hf * 2 + bl) * SEQ + c * 128) * 64;
  const float lg = logf(1.0f - ex2(-5.0f - (float)hd));
#pragma unroll
  for (int it = 0; it < 2; ++it) {
    const int idx = tid + it * NTHR, j = idx >> 3, dg = idx & 7;
    const bf16_t* base = projb + (size_t)(c * 128 + j) * NP;
    float q1[8], q2[8], k1[8], k2[8];
    unpack8(*(const uint4*)(base + C_RQ + hd * 128 + dg * 8), q1); unpack8(*(const uint4*)(base + C_RQ + hd * 128 + 64 + dg * 8), q2);
    unpack8(*(const uint4*)(base + C_RK + hd * 128 + dg * 8), k1); unpack8(*(const uint4*)(base + C_RK + hd * 128 + 64 + dg * 8), k2);
    float oq1[8], oq2[8], ok1[8], ok2[8];
#pragma unroll
    for (int e = 0; e < 8; ++e) {
      const float2 t = cs[j * 64 + dg * 8 + e];
      oq1[e] = q1[e] * t.x - q2[e] * t.y; oq2[e] = q1[e] * t.y + q2[e] * t.x;
      ok1[e] = (k1[e] * t.x - k2[e] * t.y) * 0.08838834764831845f; ok2[e] = (k1[e] * t.y + k2[e] * t.x) * 0.08838834764831845f;
    }
    *(uint4*)(sQ + j * LD + dg * 8) = pack8(oq1); *(uint4*)(sQ + j * LD + 64 + dg * 8) = pack8(oq2);
    *(uint4*)(sK + j * LD + dg * 8) = pack8(ok1); *(uint4*)(sK + j * LD + 64 + dg * 8) = pack8(ok2);
    *(uint4*)(sVt + j * LD + dg * 16) = *(const uint4*)(base + C_RV + hd * 128 + dg * 16);
    *(uint4*)(sVt + j * LD + dg * 16 + 8) = *(const uint4*)(base + C_RV + hd * 128 + dg * 16 + 8);
  }
  __syncthreads();
  const int wid = tid >> 6, lane = tid & 63, fr = lane & 15, fq = lane >> 4;
  const int i_row = 16 * wid + fr;
  uint4 stv0, stv1, stv2, stv3; uint2 gv8[8];
  {
    const bf16_t* st = (const bf16_t*)(wsb + WS_RST) + (size_t)((bl * 64 + c) * 4 + hd) * 16384;
    { const int e0 = tid >> 3, dg = tid & 7; stv0 = *(const uint4*)(st + e0 * 128 + dg * 16); stv1 = *(const uint4*)(st + e0 * 128 + dg * 16 + 8); stv2 = *(const uint4*)(st + (e0 + 64) * 128 + dg * 16); stv3 = *(const uint4*)(st + (e0 + 64) * 128 + dg * 16 + 8); }
    const bf16_t* gp0 = projb + (size_t)(c * 128 + i_row) * NP + C_RG + hd * 128 + 4 * fq;
#pragma unroll
    for (int n = 0; n < 8; ++n) gv8[n] = *(const uint2*)(gp0 + 16 * n);
  }
  {
    bf16x8 aq[4];
#pragma unroll
    for (int ks = 0; ks < 4; ++ks) aq[ks] = ldf(sQ, LD, 16 * wid, 32 * ks, fr, fq);
#pragma unroll
    for (int n = 0; n < 8; ++n) {
      if (n <= (wid | 1)) {
        uint2 w; w.x = 0u; w.y = 0u;
        if (n <= wid) {
          f32x4 s = (f32x4){0.f, 0.f, 0.f, 0.f};
#pragma unroll
          for (int ks = 0; ks < 4; ++ks) s = mmaT(aq[ks], ldf(sK, LD, 16 * n, 32 * ks, fr, fq), s);
          float r[4];
#pragma unroll
          for (int j = 0; j < 4; ++j) { const int d = i_row - (16 * n + 4 * fq + j); r[j] = (d >= 0) ? s[j] * __expf(lg * (float)d) : 0.f; }
          w.x = pk2(r[0], r[1]); w.y = pk2(r[2], r[3]);
        }
        *(uint2*)(sS + i_row * LD + 16 * n + 4 * fq) = w;
      }
    }
  }
  f32x4 o1[8];
#pragma unroll
  for (int n = 0; n < 8; ++n) o1[n] = (f32x4){0.f, 0.f, 0.f, 0.f};
  const int nks = (wid >> 1) + 1;
  for (int ks = 0; ks < nks; ++ks) {
    const bf16x8 a = ldf(sS, LD, 16 * wid, 32 * ks, fr, fq);
#pragma unroll
    for (int n = 0; n < 8; ++n) o1[n] = mmaT(a, frag_tr(sVt, LD, 32 * ks, 16 * n, fr, fq), o1[n]);
  }
  __syncthreads();
  {
    { const int e0 = tid >> 3, dg = tid & 7;
      *(uint4*)(sK + e0 * LD + dg * 16) = stv0; *(uint4*)(sK + e0 * LD + dg * 16 + 8) = stv1;
      *(uint4*)(sK + (e0 + 64) * LD + dg * 16) = stv2; *(uint4*)(sK + (e0 + 64) * LD + dg * 16 + 8) = stv3; }
  }
  __syncthreads();
  f32x4 o2[8];
#pragma unroll
  for (int n = 0; n < 8; ++n) o2[n] = (f32x4){0.f, 0.f, 0.f, 0.f};
#pragma unroll
  for (int ks = 0; ks < 4; ++ks) {
    const bf16x8 a = ldf(sQ, LD, 16 * wid, 32 * ks, fr, fq);
#pragma unroll
    for (int n = 0; n < 8; ++n) o2[n] = mmaT(a, ldf(sK, LD, 16 * n, 32 * ks, fr, fq), o2[n]);
  }
  const float dq = __expf(lg * (float)(i_row + 1));
  float ss = 0.f;
#pragma unroll
  for (int n = 0; n < 8; ++n)
#pragma unroll
    for (int j = 0; j < 4; ++j) { const float v = o1[n][j] + o2[n][j] * dq; o1[n][j] = v; ss += v * v; }
  ss += shx(ss, 16, lane); ss += shx(ss, 32, lane);
  const float rinv = rsqrtf(ss * (1.0f / 128.0f) + EPS);
  bf16_t* gp = projb + (size_t)(c * 128 + i_row) * NP + C_RG + hd * 128 + 4 * fq;
#pragma unroll
  for (int n = 0; n < 8; ++n) {
    const uint2 gv = gv8[n];
    uint2 w;
    w.x = pk2(o1[n][0] * rinv * silu_f(bflo(gv.x)), o1[n][1] * rinv * silu_f(bfhi(gv.x)));
    w.y = pk2(o1[n][2] * rinv * silu_f(bflo(gv.y)), o1[n][3] * rinv * silu_f(bfhi(gv.y)));
    if (!dry || rinv == 1.2345e-30f) *(uint2*)(gp + 16 * n) = w;
  }
  __syncthreads();
}

DI void ssd_out_unit(const Params& p, int layer, int hf, int bl, int c, unsigned char* shm, int tid, bool dry = false) {
  unsigned char* wsb = ows(p);
  constexpr int LXS = 72;
  bf16_t* sC = (bf16_t*)shm; bf16_t* sB = sC + 128 * LD; bf16_t* sM = sB; bf16_t* sX = sB + 128 * LD; bf16_t* sSp = sX + 128 * LXS;
  float* sDt = (float*)(sSp + 64 * LD); float* sAc = sDt + 16 * 128;
  bf16_t* projb = (bf16_t*)(wsb + WS_PROJ) + (size_t)bl * SEQ * NP;
  const bf16_t* xcb = (const bf16_t*)(wsb + WS_XC) + (size_t)(bl * SEQ + c * 128) * 1536;
  const float* tail = (const float*)(wsb + WS_TAIL) + (size_t)((hf * 2 + bl) * SEQ + c * 128) * 24;
  const int wid = tid >> 6, lane = tid & 63, fr = lane & 15, fq = lane >> 4;
  const int i_row = 16 * wid + fr;
#pragma unroll
  for (int q = 0; q < 2; ++q) {
    const int h = 2 * wid + q; const float Ah = -__expf(p.a_log[layer * 16 + h]);
    const float d0 = tail[(2 * lane) * 24 + h], d1 = tail[(2 * lane + 1) * 24 + h];
    float c0, c1, last; wave_cumsum128(d0 * Ah, d1 * Ah, lane, c0, c1, last);
    sDt[h * 128 + 2 * lane] = d0; sDt[h * 128 + 2 * lane + 1] = d1; sAc[h * 128 + 2 * lane] = c0; sAc[h * 128 + 2 * lane + 1] = c1;
  }
  float ssq = 0.f;
  for (int g = 0; g < 2; ++g) {
    __syncthreads();
#pragma unroll
    for (int it = 0; it < 4; ++it) {
      const int idx = tid + it * NTHR, j = idx >> 4, ng = idx & 15;
      *(uint4*)(sC + j * LD + ng * 8) = *(const uint4*)(xcb + (size_t)j * 1536 + 1280 + g * 128 + ng * 8);
      *(uint4*)(sB + j * LD + ng * 8) = *(const uint4*)(xcb + (size_t)j * 1536 + 1024 + g * 128 + ng * 8);
    }
    __syncthreads();
    f32x4 cbv[8];
    {
      bf16x8 ac[4];
#pragma unroll
      for (int ks = 0; ks < 4; ++ks) ac[ks] = ldf(sC, LD, 16 * wid, 32 * ks, fr, fq);
#pragma unroll
      for (int n = 0; n < 8; ++n) {
        cbv[n] = (f32x4){0.f, 0.f, 0.f, 0.f};
        if (n <= wid) {
#pragma unroll
          for (int ks = 0; ks < 4; ++ks) cbv[n] = mmaT(ac[ks], ldf(sB, LD, 16 * n, 32 * ks, fr, fq), cbv[n]);
        }
      }
    }
    __syncthreads();
    uint4 xr0, xr1, sr0, sr1;
    const int xj0 = tid >> 3, xpg = tid & 7;
    {
      const int h0 = g * 8;
      xr0 = *(const uint4*)(xcb + (size_t)xj0 * 1536 + h0 * 64 + xpg * 8); xr1 = *(const uint4*)(xcb + (size_t)(xj0 + 64) * 1536 + h0 * 64 + xpg * 8);
      const bf16_t* st = (const bf16_t*)(wsb + WS_SSTP + (size_t)hf * HROWS * DM * 2) + (size_t)((bl * 64 + c) * 16 + h0) * 8192 + xj0 * 128 + xpg * 16;
      sr0 = *(const uint4*)(st); sr1 = *(const uint4*)(st + 8);
    }
    for (int hh = 0; hh < 8; ++hh) {
      const int h = g * 8 + hh;
      *(uint4*)(sX + xj0 * LXS + xpg * 8) = xr0; *(uint4*)(sX + (xj0 + 64) * LXS + xpg * 8) = xr1;
      *(uint4*)(sSp + xj0 * LD + xpg * 16) = sr0; *(uint4*)(sSp + xj0 * LD + xpg * 16 + 8) = sr1;
      {
        const int h1 = (hh + 1 < 8) ? h + 1 : h;
        xr0 = *(const uint4*)(xcb + (size_t)xj0 * 1536 + h1 * 64 + xpg * 8); xr1 = *(const uint4*)(xcb + (size_t)(xj0 + 64) * 1536 + h1 * 64 + xpg * 8);
        const bf16_t* st = (const bf16_t*)(wsb + WS_SSTP + (size_t)hf * HROWS * DM * 2) + (size_t)((bl * 64 + c) * 16 + h1) * 8192 + xj0 * 128 + xpg * 16;
        sr0 = *(const uint4*)(st); sr1 = *(const uint4*)(st + 8);
      }
      const float ac_i = sAc[h * 128 + i_row];
#pragma unroll
      for (int n = 0; n < 8; ++n) {
        if (n <= (wid | 1)) {
          uint2 w; w.x = 0u; w.y = 0u;
          if (n <= wid) {
            const float4 acj = *(const float4*)(sAc + h * 128 + 16 * n + 4 * fq), dtj = *(const float4*)(sDt + h * 128 + 16 * n + 4 * fq);
            const int j0 = 16 * n + 4 * fq;
            const float r0 = (j0 + 0 <= i_row) ? cbv[n][0] * __expf(ac_i - acj.x) * dtj.x : 0.f;
            const float r1 = (j0 + 1 <= i_row) ? cbv[n][1] * __expf(ac_i - acj.y) * dtj.y : 0.f;
            const float r2 = (j0 + 2 <= i_row) ? cbv[n][2] * __expf(ac_i - acj.z) * dtj.z : 0.f;
            const float r3 = (j0 + 3 <= i_row) ? cbv[n][3] * __expf(ac_i - acj.w) * dtj.w : 0.f;
            w.x = pk2(r0, r1); w.y = pk2(r2, r3);
          }
          *(uint2*)(sM + i_row * LD + 16 * n + 4 * fq) = w;
        }
      }
      bf16_t* zp = projb + (size_t)(c * 128 + i_row) * NP + C_Z + h * 64 + 4 * fq;
      uint2 zv4[4];
#pragma unroll
      for (int m = 0; m < 4; ++m) zv4[m] = *(const uint2*)(zp + 16 * m);
      __syncthreads();
      f32x4 y[4], y2[4];
#pragma unroll
      for (int m = 0; m < 4; ++m) { y[m] = (f32x4){0.f, 0.f, 0.f, 0.f}; y2[m] = (f32x4){0.f, 0.f, 0.f, 0.f}; }
      const int nks = (wid >> 1) + 1;
      for (int ks = 0; ks < nks; ++ks) {
        const bf16x8 a = ldf(sM, LD, 16 * wid, 32 * ks, fr, fq);
#pragma unroll
        for (int m = 0; m < 4; ++m) y[m] = mmaT(a, frag_tr(sX, LXS, 32 * ks, 16 * m, fr, fq), y[m]);
      }
#pragma unroll
      for (int ks = 0; ks < 4; ++ks) {
        const bf16x8 a = ldf(sC, LD, 16 * wid, 32 * ks, fr, fq);
#pragma unroll
        for (int m = 0; m < 4; ++m) y2[m] = mmaT(a, ldf(sSp, LD, 16 * m, 32 * ks, fr, fq), y2[m]);
      }
      const float ei = __expf(ac_i), Dh = p.d_skip[layer * 16 + h];
#pragma unroll
      for (int m = 0; m < 4; ++m) {
        const uint2 zv = zv4[m];
        const uint2 xv = *(const uint2*)(sX + i_row * LXS + 16 * m + 4 * fq);
        const float zz[4] = {bflo(zv.x), bfhi(zv.x), bflo(zv.y), bfhi(zv.y)};
        const float xs[4] = {bflo(xv.x), bfhi(xv.x), bflo(xv.y), bfhi(xv.y)};
        float r[4];
#pragma unroll
        for (int j = 0; j < 4; ++j) {
          const float v = (y[m][j] + ei * y2[m][j] + Dh * xs[j]) * silu_f(zz[j]);
          r[j] = v; ssq += v * v;
        }
        uint2 w; w.x = pk2(r[0], r[1]); w.y = pk2(r[2], r[3]);
        if (!dry || ssq == 1.2345e-30f) *(uint2*)(zp + 16 * m) = w;
      }
      __syncthreads();
    }
  }
  ssq += shx(ssq, 16, lane); ssq += shx(ssq, 32, lane);
  const float rinv = rsqrtf(ssq * (1.0f / 1024.0f) + EPS);
  const float* gn = p.ssd_norm_g + layer * 1024;
  bf16_t* zr = projb + (size_t)(c * 128 + i_row) * NP + C_Z + 4 * fq;
  for (int t0 = 0; t0 < 64; t0 += 8) {
    uint2 v8[8]; float4 g8[8];
#pragma unroll
    for (int q = 0; q < 8; ++q) { v8[q] = *(const uint2*)(zr + 16 * (t0 + q)); g8[q] = *(const float4*)(gn + 16 * (t0 + q) + 4 * fq); }
#pragma unroll
    for (int q = 0; q < 8; ++q) {
      uint2 w; w.x = pk2(bflo(v8[q].x) * rinv * g8[q].x, bfhi(v8[q].x) * rinv * g8[q].y); w.y = pk2(bflo(v8[q].y) * rinv * g8[q].z, bfhi(v8[q].y) * rinv * g8[q].w);
      *(uint2*)(zr + 16 * (t0 + q)) = w;
    }
  }
  __syncthreads();
}

template <bool DIAG>
DI void fox_tile(const bf16_t* sK, const bf16_t* sV, const float* sFk, const bf16x8 (&qf)[2][2], f32x4 (&o)[2][4], float (&mrun)[2], float (&lsum)[2], int key0, int qg0, int fr, int fq, int lane) {
  const float SC2 = 0.125f * LOG2E;
  f32x4 s[2][4];
  const int kof = (fr * 64 + fq * 16) ^ ((fr >> 3) << 5);
#pragma unroll
  for (int t = 0; t < 4; ++t) {
    const bf16x8 k0 = *(const bf16x8*)((const unsigned char*)sK + (t * 2) * 1024 + kof), k1 = *(const bf16x8*)((const unsigned char*)sK + (t * 2 + 1) * 1024 + kof);
#pragma unroll
    for (int mi = 0; mi < 2; ++mi) { s[mi][t] = mmaT(qf[mi][0], k0, (f32x4){0.f, 0.f, 0.f, 0.f}); s[mi][t] = mmaT(qf[mi][1], k1, s[mi][t]); }
  }
  f32x4 fk[4];
#pragma unroll
  for (int t = 0; t < 4; ++t) fk[t] = *(const f32x4*)(sFk + 16 * t + 4 * fq);
  __builtin_amdgcn_sched_barrier(0);
  bf16x8 vf[2][4];
#pragma unroll
  for (int k2 = 0; k2 < 2; ++k2)
#pragma unroll
    for (int d = 0; d < 4; ++d) {
      const bf16_t* a = sV + (32 * k2 + 4 * fq + (fr >> 2)) * 72 + 16 * d + 4 * (fr & 3);
      const v4i16_t lo = tr_rd(a), hi = tr_rd(a + 16 * 72);
      vf[k2][d] = __builtin_shufflevector(lo, hi, 0, 1, 2, 3, 4, 5, 6, 7);
    }
  __builtin_amdgcn_sched_barrier(0);
#pragma unroll
  for (int mi = 0; mi < 2; ++mi) {
    float mx = -INFINITY;
#pragma unroll
    for (int t = 0; t < 4; ++t)
#pragma unroll
      for (int j = 0; j < 4; ++j) {
        float x = __builtin_fmaf(s[mi][t][j], SC2, fk[t][j]);
        if (DIAG) { if (key0 + 16 * t + 4 * fq + j > qg0 + 16 * mi) x = -INFINITY; }
        s[mi][t][j] = x; mx = fmaxf(mx, x);
      }
    mx = fmaxf(mx, shx(mx, 16, lane)); mx = fmaxf(mx, shx(mx, 32, lane));
    const float mnew = fmaxf(mrun[mi], mx), alpha = ex2(mrun[mi] - mnew);
    mrun[mi] = mnew;
    float ps = 0.f;
#pragma unroll
    for (int t = 0; t < 4; ++t)
#pragma unroll
      for (int j = 0; j < 4; ++j) { const float pv = ex2(s[mi][t][j] - mnew); s[mi][t][j] = pv; ps += pv; }
    lsum[mi] = lsum[mi] * alpha + ps;
#pragma unroll
    for (int d = 0; d < 4; ++d) o[mi][d] *= alpha;
  }
#pragma unroll
  for (int k2 = 0; k2 < 2; ++k2) {
    bf16x8 pa[2];
#pragma unroll
    for (int mi = 0; mi < 2; ++mi) pa[mi] = mk8(pk2(s[mi][2 * k2][0], s[mi][2 * k2][1]), pk2(s[mi][2 * k2][2], s[mi][2 * k2][3]), pk2(s[mi][2 * k2 + 1][0], s[mi][2 * k2 + 1][1]), pk2(s[mi][2 * k2 + 1][2], s[mi][2 * k2 + 1][3]));
#pragma unroll
    for (int d = 0; d < 4; ++d) {
#pragma unroll
      for (int mi = 0; mi < 2; ++mi) o[mi][d] = mmaT(pa[mi], vf[k2][d], o[mi][d]);
    }
  }
}

DI void fox_unit(const Params& p, int hf, int bl, int fh, int qb, unsigned char* shm, int tid, bool dry = false) {
  unsigned char* wsb = ows(p);
  constexpr int STG = 64 * 72 * 2 * 2 + 256;
  bf16_t* projb = (bf16_t*)(wsb + WS_PROJ) + (size_t)bl * SEQ * NP;
  const float* F = (const float*)(wsb + WS_TAIL) + (size_t)((hf * 2 + bl) * SEQ) * 24 + 16 + fh;
  const int wid = tid >> 6, lane = tid & 63, fr = lane & 15, fq = lane >> 4;
  const int q0 = qb * 256, qg0 = q0 + wid * 32 + fr;
  bf16x8 qf[2][2];
#pragma unroll
  for (int mi = 0; mi < 2; ++mi)
#pragma unroll
    for (int ks = 0; ks < 2; ++ks) {
      const uint4 raw = *(const uint4*)(projb + (size_t)(qg0 + 16 * mi) * NP + C_FQ + fh * 64 + ks * 32 + fq * 8);
      qf[mi][ks] = __builtin_bit_cast(bf16x8, raw);
    }
  float qmax2 = 0.f;
#pragma unroll
  for (int mi = 0; mi < 2; ++mi) {
    float ssum = 0.f;
#pragma unroll
    for (int ks = 0; ks < 2; ++ks) { float f[8]; unpack8(__builtin_bit_cast(uint4, qf[mi][ks]), f);
#pragma unroll
      for (int z = 0; z < 8; ++z) ssum += f[z] * f[z]; }
    ssum += shx(ssum, 16, lane); ssum += shx(ssum, 32, lane);
    qmax2 = fmaxf(qmax2, ssum);
  }
#pragma unroll
  for (int o_ = 8; o_ >= 1; o_ >>= 1) qmax2 = fmaxf(qmax2, shx(qmax2, o_, lane));
  float* sRed = (float*)(shm + 2 * STG);
  if (lane == 0) sRed[wid] = qmax2;
  const float Fref = F[(size_t)q0 * 24];
  __syncthreads();
  float qm2 = 0.f;
#pragma unroll
  for (int i = 0; i < 8; ++i) qm2 = fmaxf(qm2, sRed[i]);
  const float kmax2 = ((const float*)(wsb + WS_KMAX))[bl * 8 + fh];
  const float thr = -110.0f - 0.25f * sqrtf(qm2 * kmax2) * 1.02f;
  const int nkt = 4 * qb + 4;
  int skip = 0;
  if (tid < 4 * qb) skip = (Fref - F[(size_t)(tid * 64 + 63) * 24] < thr) ? 1 : 0;
  const unsigned long long bal = __builtin_amdgcn_ballot_w64(skip != 0);
  if (lane == 0) ((int*)sRed)[8 + wid] = __builtin_popcountll(bal);
  __syncthreads();
  int kt0 = 0;
#pragma unroll
  for (int i = 0; i < 8; ++i) kt0 += ((const int*)sRed)[8 + i];
  f32x4 o[2][4];
#pragma unroll
  for (int mi = 0; mi < 2; ++mi)
#pragma unroll
    for (int d = 0; d < 4; ++d) o[mi][d] = (f32x4){0.f, 0.f, 0.f, 0.f};
  float mrun[2] = {-1e30f, -1e30f}, lsum[2] = {0.f, 0.f};
  const int skey = tid >> 3, sdg = tid & 7;
  const int kst = ((skey >> 4) * 2 + (sdg >> 2)) * 1024 + ((((skey & 15) * 64) + (sdg & 3) * 16) ^ (((skey >> 3) & 1) << 5));
  uint4 kreg, vreg; float freg = 0.f;
  {
    const size_t r = (size_t)(kt0 * 64 + skey) * NP;
    kreg = *(const uint4*)(projb + r + C_FK + fh * 64 + sdg * 8); vreg = *(const uint4*)(projb + r + C_FV + fh * 64 + sdg * 8);
    if (tid < 64) freg = (Fref - F[(size_t)(kt0 * 64 + tid) * 24]) * LOG2E;
  }
  {
    bf16_t* sK = (bf16_t*)(shm + (kt0 & 1) * STG); bf16_t* sV = sK + 64 * 72; float* sFk = (float*)(sV + 64 * 72);
    *(uint4*)((unsigned char*)sK + kst) = kreg; *(uint4*)(sV + skey * 72 + sdg * 8) = vreg;
    if (tid < 64) sFk[tid] = freg;
  }
  __syncthreads();
  for (int kt = kt0; kt < nkt; ++kt) {
    const int st = kt & 1;
    if (kt + 1 < nkt) {
      const size_t r = (size_t)((kt + 1) * 64 + skey) * NP;
      kreg = *(const uint4*)(projb + r + C_FK + fh * 64 + sdg * 8); vreg = *(const uint4*)(projb + r + C_FV + fh * 64 + sdg * 8);
      if (tid < 64) freg = (Fref - F[(size_t)((kt + 1) * 64 + tid) * 24]) * LOG2E;
    }
    const bf16_t* sK = (const bf16_t*)(shm + st * STG); const bf16_t* sV = sK + 64 * 72; const float* sFk = (const float*)(sV + 64 * 72);
    if (kt * 64 <= q0 + wid * 32 + 31) {
      if (kt >= 4 * qb) fox_tile<true>(sK, sV, sFk, qf, o, mrun, lsum, kt * 64, qg0, fr, fq, lane);
      else fox_tile<false>(sK, sV, sFk, qf, o, mrun, lsum, kt * 64, qg0, fr, fq, lane);
    }
    if (kt + 1 < nkt) {
      bf16_t* nK = (bf16_t*)(shm + (st ^ 1) * STG); bf16_t* nV = nK + 64 * 72; float* nF = (float*)(nV + 64 * 72);
      *(uint4*)((unsigned char*)nK + kst) = kreg; *(uint4*)(nV + skey * 72 + sdg * 8) = vreg;
      if (tid < 64) nF[tid] = freg;
    }
    __syncthreads();
  }
#pragma unroll
  for (int mi = 0; mi < 2; ++mi) {
    float l = lsum[mi]; l += shx(l, 16, lane); l += shx(l, 32, lane);
    const float inv = 1.0f / l;
    bf16_t* gp = projb + (size_t)(qg0 + 16 * mi) * NP + C_FG + fh * 64 + 4 * fq;
#pragma unroll
    for (int d = 0; d < 4; ++d) {
      const uint2 gv = *(const uint2*)(gp + 16 * d);
      uint2 w;
      w.x = pk2(o[mi][d][0] * inv * silu_f(bflo(gv.x)), o[mi][d][1] * inv * silu_f(bfhi(gv.x)));
      w.y = pk2(o[mi][d][2] * inv * silu_f(bflo(gv.y)), o[mi][d][3] * inv * silu_f(bfhi(gv.y)));
      if (!dry || inv == 1.2345e-30f) *(uint2*)(gp + 16 * d) = w;
    }
  }
}

#define XB_TMO      128
#define XB_XCNT(j)  (256  + 64 * (j))
#define XB_XSUB(j)  (1280 + 64 * (j))
#define XB_XGEN(j)  (2304 + 64 * (j))
#define XB_TOP      3328
#define XB_TOPGEN   3392
#define XCD_BAR_WORDS 3456
#define XB_SPIN_CAP (1u << 20)
DI unsigned xb_ld(unsigned* p) { return __hip_atomic_load(p, __ATOMIC_RELAXED, __HIP_MEMORY_SCOPE_AGENT); }
DI unsigned xb_add(unsigned* p, unsigned v) { return __hip_atomic_fetch_add(p, v, __ATOMIC_RELAXED, __HIP_MEMORY_SCOPE_AGENT); }
DI unsigned xb_xcc_id() { return (unsigned)__builtin_amdgcn_s_getreg((3 << 11) | 20) & 0xFu; }
#define XB_SPIN(cond, bar) do { unsigned _sp = 0; while (cond) { __builtin_amdgcn_s_sleep(1); \
    if ((++_sp & 255u) == 0u) { if (xb_ld(&(bar)[XB_TMO])) break; if (_sp > XB_SPIN_CAP) { atomicAdd(&(bar)[XB_TMO], 1u); break; } } } } while (0)
struct XcdBarrier { unsigned* bar; unsigned x; volatile LDSP unsigned* st; };
DI XcdBarrier xcd_barrier_post(unsigned* bar, volatile LDSP unsigned* st) {
  XcdBarrier b; b.bar = bar; b.x = xb_xcc_id(); b.st = st;
  if (threadIdx.x == 0) (void)xb_add(&bar[XB_XCNT(b.x)], 1u);
  return b;
}
DI void xcd_barrier_complete(unsigned* bar, unsigned x, unsigned& nloc, unsigned& nx) {
  const unsigned G = gridDim.x;
  unsigned sum, cnt, mine, sp = 0u;
  for (;;) {
    sum = 0u; cnt = 0u; mine = 0u;
#pragma unroll
    for (unsigned j = 0; j < 16; ++j) { const unsigned c = xb_ld(&bar[XB_XCNT(j)]); sum += c; cnt += (c > 0u) ? 1u : 0u; mine = (j == x) ? c : mine; }
    if (sum == G) break;
    __builtin_amdgcn_s_sleep(1);
    if ((++sp & 255u) == 0u) { if (xb_ld(&bar[XB_TMO])) break; if (sp > XB_SPIN_CAP) { atomicAdd(&bar[XB_TMO], 1u); break; } }
  }
  nloc = mine > 0u ? mine : 1u; nx = cnt > 0u ? cnt : 1u;
}
DI void xcd_barrier(const XcdBarrier& b) {
  asm volatile("s_waitcnt vmcnt(0)" ::: "memory");
  __syncthreads();
  if (threadIdx.x == 0) {
    unsigned* bar = b.bar;
    __builtin_amdgcn_s_waitcnt(0);
    unsigned nloc = b.st[0], nx = b.st[1];
    if (nloc == 0u) { xcd_barrier_complete(bar, b.x, nloc, nx); b.st[0] = nloc; b.st[1] = nx; }
    const unsigned old = xb_add(&bar[XB_XSUB(b.x)], 1u);
    const unsigned gen = old / nloc;
    if (old + 1u == (gen + 1u) * nloc) {
      __builtin_amdgcn_fence(__ATOMIC_RELEASE, "agent");
      asm volatile("s_waitcnt vmcnt(0)" ::: "memory");
      const unsigned og = xb_add(&bar[XB_TOP], 1u);
      const unsigned tg = og / nx;
      if (og + 1u == (tg + 1u) * nx) xb_add(&bar[XB_TOPGEN], 1u);
      else XB_SPIN(xb_ld(&bar[XB_TOPGEN]) == tg, bar);
      __builtin_amdgcn_fence(__ATOMIC_ACQUIRE, "agent");
      xb_add(&bar[XB_XGEN(b.x)], 1u);
      asm volatile("s_waitcnt vmcnt(0)" ::: "memory");
    } else {
      XB_SPIN(xb_ld(&bar[XB_XGEN(b.x)]) == gen, bar);
      __builtin_amdgcn_fence(__ATOMIC_ACQUIRE, "agent");
      asm volatile("s_waitcnt vmcnt(0)" ::: "memory");
    }
  }
  __syncthreads();
}

DI int otid_(int wbase) { int t = wbase + (int)__builtin_amdgcn_mbcnt_hi(~0u, __builtin_amdgcn_mbcnt_lo(~0u, 0u)); asm volatile("" : "+v"(t)); return t; }
#define otid() otid_(wbase)
__global__ void __launch_bounds__(NTHR) mega(Params p) {
  extern __shared__ __attribute__((aligned(16))) unsigned char shm[];
  __shared__ uint4 s_words[2];
#define s_unit (*(int*)&s_words[1])
  cg::grid_group grid = cg::this_grid();
  const int wbase = __builtin_amdgcn_readfirstlane((int)(threadIdx.x & ~63u));
  const int tid = threadIdx.x;
  if (tid == 0) { s_words[0] = make_uint4(0u, 0u, 0u, 0u); s_words[1] = make_uint4(0u, 0u, 0u, 0u); }
  __syncthreads();
  int* ctr = (int*)(p.ws + WS_CTR);
  int phase_id = 0;
#ifndef X_P0
  phase0(p, shm, otid());
#endif
  grid.sync();
  (void)xcd_barrier_post((unsigned*)(ows(p) + WS_BAR), (volatile LDSP unsigned*)&s_words[0]);
#define GSYNC() do { XcdBarrier xb_; xb_.bar = (unsigned*)(ows(p) + WS_BAR); xb_.x = xb_xcc_id(); xb_.st = (volatile LDSP unsigned*)&s_words[0]; xcd_barrier(xb_); } while (0)
#if defined(PROBE_SYNC)
  for (int i = 0; i < 45; ++i) GSYNC();
#endif
  for (int layer = 0; layer < NLAYER; ++layer) {
    if (layer == 0) { norm_phase(p, 0, otid()); GSYNC(); }
    for (int hf = 0; hf < 2; ++hf) {
#ifndef X_G0
      gemm_phase<0>(p, layer, hf, shm, otid());
#endif
#if defined(PROBE_G0)
      gemm_phase<0>(p, layer, hf, shm, otid());
#endif
      GSYNC();
#if defined(PROBE_P2)
      for (int u = 16 + blockIdx.x; u < 16 + 256 + 512; u += gridDim.x) {
        if (u < 272) { const int k = u - 16; ssd_local_unit(p, layer, hf, k >> 7, (k >> 1) & 63, k & 1, shm, otid()); }
        else { const int k = u - 272; ret_local_unit(p, hf, k >> 8, (k >> 2) & 63, k & 3, shm, otid()); }
      }
#endif
      {
        int* my = ctr + 8 + phase_id;
        for (;;) {
          __syncthreads();
          if (otid() == 0) s_unit = atomicAdd(my, 1);
          __syncthreads();
          const int u0 = s_unit;
          const int n_fill = (hf == 0 && layer > 0) ? 256 : 0;
          int u = u0;
          if (u >= 784 + n_fill) break;
          if (u >= 16 && u < 16 + n_fill) { norm_unit(p, layer, 1, u - 16, otid()); continue; }
          if (u >= 16) u -= n_fill;
          if (u < 16) fox_cumsum_unit(p, hf, u >> 3, u & 7, shm, otid());
          else if (u < 272) { const int k = u - 16; ssd_local_unit(p, layer, hf, k >> 7, (k >> 1) & 63, k & 1, shm, otid()); }
          else { const int k = u - 272; ret_local_unit(p, hf, k >> 8, (k >> 2) & 63, k & 3, shm, otid()); }
        }
      }
      GSYNC();
      {
        int* my = ctr + phase_id; int* dep = ctr + 64 + phase_id; ++phase_id;
        bool dep_ok = false;
        for (;;) {
          __syncthreads();
          if (otid() == 0) s_unit = atomicAdd(my, 1);
          __syncthreads();
          const int u0 = s_unit;
          const int n_fill = (hf == 1) ? 256 : 0;
          int u = u0;
          if (u >= 1344 + n_fill) break;
          if (u >= 448 && u < 448 + n_fill) { norm_unit(p, layer + 1, 0, u - 448, otid()); continue; }
          if (u >= 448) u -= n_fill;
          const bool needs = (u >= 448 && u < 576) || (u >= 832);
          if (needs && !dep_ok) {
            if (otid() == 0) {
              unsigned sp = 0;
              while (__hip_atomic_load(dep, __ATOMIC_RELAXED, __HIP_MEMORY_SCOPE_AGENT) < 192) { __builtin_amdgcn_s_sleep(2); if (++sp > (1u << 22)) break; }
              __builtin_amdgcn_fence(__ATOMIC_ACQUIRE, "agent");
              asm volatile("s_waitcnt vmcnt(0)" ::: "memory");
            }
            __syncthreads();
            dep_ok = true;
          }
          if (u < 256) { fox_unit(p, hf, (u >> 3) & 1, u & 7, 31 - (u >> 4), shm, otid()); }
          else if (u < 448) {
            scan_unit(p, hf, u - 256, otid());
            asm volatile("s_waitcnt vmcnt(0)" ::: "memory");
            __syncthreads();
            if (otid() == 0) { __builtin_amdgcn_fence(__ATOMIC_RELEASE, "agent"); asm volatile("s_waitcnt vmcnt(0)" ::: "memory"); __hip_atomic_fetch_add(dep, 1, __ATOMIC_RELAXED, __HIP_MEMORY_SCOPE_AGENT); }
          }
          else if (u < 576) { const int k = u - 448; ssd_out_unit(p, layer, hf, k >> 6, k & 63, shm, otid()); }
          else if (u < 832) { const int k = u - 576 + 256; fox_unit(p, hf, (k >> 3) & 1, k & 7, 31 - (k >> 4), shm, otid()); }
          else { const int k = u - 832; ret_out_unit(p, hf, k >> 8, (k >> 2) & 63, k & 3, shm, otid()); }
        }
      }
      GSYNC();
#ifndef X_G1
      gemm_phase<1>(p, layer, hf, shm, otid());
#endif
      GSYNC();
    }
  }
  norm_rows(p, NLAYER, HROWS, HROWS, blockIdx.x * 8, gridDim.x * 8, otid());
}

extern "C" void kernel_launch(void* const* d_in, const int* in_sizes, int n_in, void* d_out, int out_size, void* d_ws, size_t ws_size, hipStream_t stream) {
  static int grid = 0;
  if (grid == 0) {
    int dev = 0, cus = 0, per_cu = 0;
    hipGetDevice(&dev);
    hipDeviceGetAttribute(&cus, hipDeviceAttributeMultiprocessorCount, dev);
    hipFuncSetAttribute((const void*)mega, hipFuncAttributeMaxDynamicSharedMemorySize, LDS_BYTES);
    if (hipOccupancyMaxActiveBlocksPerMultiprocessor(&per_cu, (const void*)mega, NTHR, LDS_BYTES) != hipSuccess || per_cu < 1) per_cu = 1;
    (void)hipGetLastError();
    grid = cus * per_cu;
    if (ws_size < WS_END || n_in != 16) { fprintf(stderr, "kernel_launch: workspace %zu < %zu or n_in %d != 16\n", ws_size, (size_t)WS_END, n_in); grid = -1; }
  }
  if (grid < 0) return;
  Params p{};
  p.x = (const float*)d_in[0]; p.c = (const float*)d_in[1]; p.pos = (const int*)d_in[2]; p.norm_g = (const float*)d_in[3];
  p.w_ada = (const float*)d_in[4]; p.b_ada = (const float*)d_in[5]; p.w_in = (const float*)d_in[6]; p.conv_w = (const float*)d_in[7];
  p.conv_b = (const float*)d_in[8]; p.dt_bias = (const float*)d_in[9]; p.a_log = (const float*)d_in[10]; p.d_skip = (const float*)d_in[11];
  p.ssd_norm_g = (const float*)d_in[12]; p.b_forget = (const float*)d_in[13]; p.w_out = (const float*)d_in[14]; p.final_g = (const float*)d_in[15];
  p.out = (float*)d_out; p.ws = (unsigned char*)d_ws;
  void* args[] = {&p};
  hipError_t e = hipLaunchCooperativeKernel((const void*)mega, dim3(grid), dim3(NTHR), args, LDS_BYTES, stream);
  if (e != hipSuccess) fprintf(stderr, "cooperative launch failed: %s (grid %d)\n", hipGetErrorString(e), grid);
}
```

```cpp
#include <hip/hip_runtime.h>
#include <hip/hip_cooperative_groups.h>
#include <cstdio>
#include <cmath>
namespace cg = cooperative_groups;

#define DI __device__ __forceinline__
typedef unsigned short bf16_t;
typedef short bf16x8 __attribute__((ext_vector_type(8)));
typedef float f32x4 __attribute__((ext_vector_type(4)));

constexpr int SEQ = 8192, DM = 1024, NLAYER = 4, ROWS = 32768, HROWS = 16384;
constexpr int NP = 6656;
constexpr int NWIN = 6912;
constexpr int NIN = 6680;
constexpr int C_RQ = 0, C_RK = 512, C_RV = 1024, C_XS = 1536, C_FQ = 3072, C_FK = 3584, C_FV = 4096, C_RG = 4608, C_Z = 5120, C_FG = 6144;
constexpr int NTHR = 512;
constexpr int LDS_BYTES = 147456;
constexpr float LOG2E = 1.4426950408889634f;
constexpr float EPS = 1e-6f;

constexpr size_t WS_PROJ = 0;
constexpr size_t WS_H = WS_PROJ + (size_t)HROWS * NP * 2;
constexpr size_t WS_SSTP = WS_H;
constexpr size_t WS_WIN = WS_H + (size_t)ROWS * DM * 2;
constexpr size_t WS_WOUT = WS_WIN + (size_t)NLAYER * NWIN * 1024 * 2;
constexpr size_t WS_RST = WS_WOUT + (size_t)NLAYER * 1024 * 2048 * 2;
constexpr size_t WS_SST = WS_RST + (size_t)2 * 64 * 4 * 16384 * 4;
constexpr size_t WS_CS = WS_SST + (size_t)2 * 64 * 16 * 8192 * 4;
constexpr size_t WS_TAIL = WS_CS + (size_t)ROWS * 64 * 8;
constexpr size_t WS_MOD = WS_TAIL + (size_t)ROWS * 24 * 4;
constexpr size_t WS_ASUM = WS_MOD + (size_t)NLAYER * 4 * 3072 * 4;
constexpr size_t WS_CTR = WS_ASUM + (size_t)2 * 64 * 16 * 4;
constexpr size_t WS_XC = WS_CTR + 1024;
constexpr size_t WS_BAR = WS_XC + (size_t)HROWS * 1536 * 2;
constexpr size_t WS_KMAX = WS_BAR + 16384;
constexpr size_t WS_FC = WS_KMAX + 256;
constexpr size_t WS_END = WS_FC + (size_t)2 * 8 * SEQ * 4;

struct Params {
  const float* x; const float* c; const int* pos; const float* norm_g; const float* w_ada; const float* b_ada;
  const float* w_in; const float* conv_w; const float* conv_b; const float* dt_bias; const float* a_log;
  const float* d_skip; const float* ssd_norm_g; const float* b_forget; const float* w_out; const float* final_g;
  float* out; unsigned char* ws;
};

DI unsigned pk2(float lo, float hi) { unsigned r; asm volatile("v_cvt_pk_bf16_f32 %0, %1, %2" : "=v"(r) : "v"(lo), "v"(hi)); return r; }
DI float bflo(unsigned u) { return __uint_as_float(u << 16); }
DI float bfhi(unsigned u) { return __uint_as_float(u & 0xffff0000u); }
DI float bf2f(bf16_t v) { return __uint_as_float(((unsigned)v) << 16); }
DI bf16_t f2bf(float f) { unsigned u = __float_as_uint(f); u += 0x7fffu + ((u >> 16) & 1u); return (bf16_t)(u >> 16); }
DI void unpack8(uint4 v, float* f) { f[0] = bflo(v.x); f[1] = bfhi(v.x); f[2] = bflo(v.y); f[3] = bfhi(v.y); f[4] = bflo(v.z); f[5] = bfhi(v.z); f[6] = bflo(v.w); f[7] = bfhi(v.w); }
DI uint4 pack8(const float* f) { uint4 r; r.x = pk2(f[0], f[1]); r.y = pk2(f[2], f[3]); r.z = pk2(f[4], f[5]); r.w = pk2(f[6], f[7]); return r; }
DI float silu_f(float x) { return x * __builtin_amdgcn_rcpf(1.0f + __expf(-x)); }
DI float softplus_f(float x) { return fmaxf(x, 0.f) + log1pf(__expf(-fabsf(x))); }
DI float ex2(float x) { return __builtin_amdgcn_exp2f(x); }
DI f32x4 mmaT(bf16x8 a_m, bf16x8 b_n, f32x4 c) { return __builtin_amdgcn_mfma_f32_16x16x32_bf16(b_n, a_m, c, 0, 0, 0); }
DI bf16x8 ldf(const bf16_t* s, int ld, int r0, int k0, int fr, int fq) { return *(const bf16x8*)(s + (r0 + fr) * ld + k0 + fq * 8); }
typedef short v4i16_t __attribute__((ext_vector_type(4)));
#define LDSP __attribute__((address_space(3)))
DI v4i16_t tr_rd(const bf16_t* a) { return __builtin_amdgcn_ds_read_tr16_b64_v4i16((LDSP v4i16_t*)a); }
DI bf16x8 frag_tr(const bf16_t* T, int ld, int k0, int n0, int fr, int fq) {
  const bf16_t* a = T + (k0 + 8 * fq + (fr >> 2)) * ld + n0 + 4 * (fr & 3);
  const v4i16_t lo = tr_rd(a), hi = tr_rd(a + 4 * ld);
  return __builtin_shufflevector(lo, hi, 0, 1, 2, 3, 4, 5, 6, 7);
}
DI float shx(float v, int m, int lane) { return __int_as_float(__builtin_amdgcn_ds_bpermute((lane ^ m) << 2, __float_as_int(v))); }
DI float shup(float v, int off, int lane) { return __int_as_float(__builtin_amdgcn_ds_bpermute((lane - off) << 2, __float_as_int(v))); }
DI bf16x8 mk8(unsigned a, unsigned b, unsigned c, unsigned d) { uint4 v; v.x = a; v.y = b; v.z = c; v.w = d; return __builtin_bit_cast(bf16x8, v); }

DI unsigned char* ows(const Params& p) { return p.ws; }
DI size_t wimg_off(int n, int k, int K) {
  const int r = n & 127, c = k & 31, ob = (r & 15) * 64 + c * 2;
  return ((size_t)(n >> 7) * (K >> 5) + (k >> 5)) * 4096 + (((r >> 4) * 1024 + (ob ^ (((ob >> 9) & 1) << 5))) >> 1);
}
DI void transpose_tile(const float* src, int src_ld, int k0, int sc0, bf16_t* dst, int dst_ld, int n0, float* sT  , int tid) {
  float4 v[8];
#pragma unroll
  for (int i = 0; i < 8; ++i) v[i] = *(const float4*)(src + (size_t)(k0 + (tid >> 6) + 8 * i) * src_ld + sc0 + (tid & 63) * 4);
#pragma unroll
  for (int i = 0; i < 8; ++i) { float* q = sT + ((tid >> 6) + 8 * i) * 257 + (tid & 63) * 4; q[0] = v[i].x; q[1] = v[i].y; q[2] = v[i].z; q[3] = v[i].w; }
  __syncthreads();
  {
    const int n = tid >> 1, kh = (tid & 1) * 32;
#pragma unroll
    for (int q = 0; q < 4; ++q) {
      const float* c = sT + (kh + 8 * q) * 257 + n;
      uint4 w;
      w.x = pk2(c[0], c[257]); w.y = pk2(c[2 * 257], c[3 * 257]); w.z = pk2(c[4 * 257], c[5 * 257]); w.w = pk2(c[6 * 257], c[7 * 257]);
      *(uint4*)(dst + wimg_off(n0 + n, k0 + kh + 8 * q, dst_ld)) = w;
    }
  }
  __syncthreads();
}

DI int win_src_col(int d) {
  if (d < 1536) return d;
  if (d < 3072) return d + 512;
  if (d < 4608) return d + 1552;
  if (d < 5120) return d - 3072;
  if (d < 6144) return d - 1520;
  return d + 16;
}

DI void phase0(const Params& p, unsigned char* shm, int tid) {
  unsigned char* wsb = ows(p);
  float* sT = (float*)shm;
  float* ssc = (float*)(shm + 69632);
  float* red = (float*)(shm + 69632 + 16384);
  bf16_t* wtin = (bf16_t*)(wsb + WS_WIN);
  bf16_t* wtout = (bf16_t*)(wsb + WS_WOUT);
  float* mod = (float*)(wsb + WS_MOD);
  for (int i = tid; i < 4096; i += NTHR) ssc[i] = silu_f(p.c[i]);
  __syncthreads();
  const int n_mod = 192, n_win = NLAYER * 16 * 26, n_wout = NLAYER * 32 * 4;
  for (int it = blockIdx.x; it < n_mod + n_win + n_wout; it += gridDim.x) {
    if (it < n_mod) {
      const int l = it / 48, cgp = it % 48, kc = tid >> 6, col = tid & 63;
      float a0 = 0.f, a1 = 0.f, a2 = 0.f, a3 = 0.f;
      const float* wp = p.w_ada + ((size_t)l * 1024 + kc * 128) * 3072 + cgp * 64 + col;
#pragma unroll 8
      for (int k = 0; k < 128; ++k) {
        const float w = wp[(size_t)k * 3072]; const int kk = kc * 128 + k;
        a0 += ssc[kk] * w; a1 += ssc[1024 + kk] * w; a2 += ssc[2048 + kk] * w; a3 += ssc[3072 + kk] * w;
      }
      red[(kc * 4 + 0) * 64 + col] = a0; red[(kc * 4 + 1) * 64 + col] = a1; red[(kc * 4 + 2) * 64 + col] = a2; red[(kc * 4 + 3) * 64 + col] = a3;
      __syncthreads();
      if (tid < 256) {
        const int b = tid >> 6, cc = tid & 63; float s = 0.f;
#pragma unroll
        for (int q = 0; q < 8; ++q) s += red[(q * 4 + b) * 64 + cc];
        mod[(size_t)(l * 4 + b) * 3072 + cgp * 64 + cc] = s + p.b_ada[l * 3072 + cgp * 64 + cc];
      }
      __syncthreads();
    } else if (it < n_mod + n_win) {
      const int j = it - n_mod, l = j / (16 * 26), r = j % (16 * 26), kt = r / 26, nt = r % 26;
      transpose_tile(p.w_in + (size_t)l * 1024 * NIN, NIN, kt * 64, win_src_col(nt * 256), wtin + (size_t)l * NWIN * 1024, 1024, nt * 256, sT, tid);
    } else {
      const int j = it - n_mod - n_win, l = j / 128, r = j % 128, kt = r / 4, nt = r % 4;
      transpose_tile(p.w_out + (size_t)l * 2048 * 1024, 1024, kt * 64, nt * 256, wtout + (size_t)l * 1024 * 2048, 2048, nt * 256, sT, tid);
    }
  }
  const int gtid = blockIdx.x * NTHR + tid, gn = gridDim.x * NTHR;
  for (int i = gtid; i < NLAYER * 256 * 1024; i += gn) {
    const int l = i / (256 * 1024), r = (i / 1024) % 256, k = i % 1024;
    float v = 0.f;
    if (r < 16) v = p.w_in[((size_t)l * 1024 + k) * NIN + 3584 + r];
    else if (r < 24) v = p.w_in[((size_t)l * 1024 + k) * NIN + 6672 + (r - 16)];
    wtin[(size_t)l * NWIN * 1024 + wimg_off(6656 + r, k, 1024)] = f2bf(v);
  }
  float2* cs = (float2*)(wsb + WS_CS);
  for (int i = gtid; i < ROWS * 64; i += gn) {
    const int row = i >> 6, fi = i & 63;
    const float ang = (float)p.pos[row] * (float)exp2(-(double)fi * (13.287712379549449 / 64.0));
    const double a = (double)ang;
    const double kq = rint(a * 0.6366197723675814);
    const float r = (float)fma(-kq, 1.5707963267948966, a);
    const float r2 = r * r;
    const float sn = r + r * r2 * (-1.6666667e-1f + r2 * (8.3333333e-3f + r2 * (-1.9841270e-4f + r2 * 2.7557319e-6f)));
    const float cn = 1.0f + r2 * (-0.5f + r2 * (4.1666667e-2f + r2 * (-1.3888889e-3f + r2 * (2.4801587e-5f + r2 * -2.7557319e-7f))));
    const int q = ((int)kq) & 3;
    float co, si;
    if (q == 0) { co = cn; si = sn; } else if (q == 1) { co = -sn; si = cn; } else if (q == 2) { co = -cn; si = -sn; } else { co = sn; si = -cn; }
    cs[i] = make_float2(co, si);
  }
  int* ctr = (int*)(wsb + WS_CTR);
  for (int i = gtid; i < 256; i += gn) ctr[i] = 0;
  unsigned* barw = (unsigned*)(wsb + WS_BAR);
  for (int i = gtid; i < 3456; i += gn) barw[i] = 0u;
}

DI void norm_rows(const Params& p, int layer, int row0, int nrows, int wstart, int wstride, int tid) {
  unsigned char* wsb = ows(p);
  const float* xin = (layer == 0) ? p.x : p.out;
  const int wid = tid >> 6, lane = tid & 63;
  bf16_t* h = (bf16_t*)(wsb + WS_H);
  const float* modb = (const float*)(wsb + WS_MOD);
  for (int rowa = row0 + wstart + wid; rowa < row0 + nrows; rowa += 2 * wstride) {
    const int rowb = (rowa + wstride < row0 + nrows) ? rowa + wstride : rowa;
    float4 va[4], vb[4]; float sa = 0.f, sb = 0.f;
#pragma unroll
    for (int i = 0; i < 4; ++i) { va[i] = *(const float4*)(xin + (size_t)rowa * DM + i * 256 + lane * 4); vb[i] = *(const float4*)(xin + (size_t)rowb * DM + i * 256 + lane * 4); }
#pragma unroll
    for (int i = 0; i < 4; ++i) { sa += va[i].x * va[i].x + va[i].y * va[i].y + va[i].z * va[i].z + va[i].w * va[i].w; sb += vb[i].x * vb[i].x + vb[i].y * vb[i].y + vb[i].z * vb[i].z + vb[i].w * vb[i].w; }
#pragma unroll
    for (int o = 32; o >= 1; o >>= 1) { sa += shx(sa, o, lane); sb += shx(sb, o, lane); }
#pragma unroll
    for (int rr = 0; rr < 2; ++rr) {
      const int row = rr ? rowb : rowa; const float rinv = rsqrtf((rr ? sb : sa) * (1.0f / 1024.0f) + EPS);
      if (layer < NLAYER) {
        const int b = row >> 13; const float* md = modb + (size_t)(layer * 4 + b) * 3072; const float* g = p.norm_g + layer * 1024;
#pragma unroll
        for (int i = 0; i < 4; ++i) {
          const float4 x4 = rr ? vb[i] : va[i];
          const int e = i * 256 + lane * 4;
          const float4 g4 = *(const float4*)(g + e), sh = *(const float4*)(md + e), sc = *(const float4*)(md + 1024 + e);
          uint2 w;
          w.x = pk2(x4.x * rinv * g4.x * (1.f + sc.x) + sh.x, x4.y * rinv * g4.y * (1.f + sc.y) + sh.y);
          w.y = pk2(x4.z * rinv * g4.z * (1.f + sc.z) + sh.z, x4.w * rinv * g4.w * (1.f + sc.w) + sh.w);
          *(uint2*)(h + wimg_off(row, e, DM)) = w;
        }
      } else {
#pragma unroll
        for (int i = 0; i < 4; ++i) {
          const float4 x4 = rr ? vb[i] : va[i];
          const int e = i * 256 + lane * 4; const float4 g4 = *(const float4*)(p.final_g + e);
          float4 o4; o4.x = x4.x * rinv * g4.x; o4.y = x4.y * rinv * g4.y; o4.z = x4.z * rinv * g4.z; o4.w = x4.w * rinv * g4.w;
          *(float4*)(p.out + (size_t)row * DM + e) = o4;
        }
      }
    }
  }
}
DI void norm_phase(const Params& p, int layer, int tid) { norm_rows(p, layer, 0, ROWS, blockIdx.x * 8, gridDim.x * 8, tid); }
DI void norm_unit(const Params& p, int layer, int half, int nu, int tid) { norm_rows(p, layer, half * HROWS + nu * 64, 64, 0, 8, tid); }
constexpr int BM = 256, BK = 64, HALF = 128, HT = HALF * BK;
DI int lds_byte(int r, int c) { int st = (r >> 4) * 2 + (c >> 5), rr = r & 15, cc = c & 31, ob = rr * 64 + cc * 2; return st * 1024 + (ob ^ (((ob >> 9) & 1) << 5)); }
DI void stage_rc(int b, int& R, int& C) { int st = b / 1024, sb = b % 1024, swz = sb ^ (((sb >> 9) & 1) << 5); R = (st >> 1) * 16 + swz / 64; C = (st & 1) * 32 + (swz % 64) / 2; }
struct Unit { int pm, pn; };
DI bool unit_next(int i, int G, int c, int nM, int nN, Unit& u) {
  const int nwg = nM * nN; const long Lx = (long)i * G + c; if (Lx >= nwg) return false;
  int wgid = (int)Lx; { const int q = nwg / 8, r = nwg % 8, xcd = wgid % 8, off = wgid / 8; wgid = (xcd < r ? xcd * (q + 1) : r * (q + 1) + (xcd - r) * q) + off; }
  const int nig = 8 * nN, gid = wgid / nig, fm = gid * 8, gsz = (nM - fm) < 8 ? (nM - fm) : 8;
  u.pm = fm + ((wgid % nig) % gsz); u.pn = (wgid % nig) / gsz; return true;
}

template <int MODE>
DI void gemm_phase(const Params& p, int layer, int hf, unsigned char* shmc, int tid) {
  unsigned char* wsb = ows(p);
  const bf16_t* A; const bf16_t* Bt; int lda, ldb, K, nM, nN;
  if (MODE == 0) { A = (const bf16_t*)(wsb + WS_H) + (size_t)hf * HROWS * DM; lda = DM; Bt = (const bf16_t*)(wsb + WS_WIN) + (size_t)layer * NWIN * 1024; ldb = 1024; K = 1024; nM = HROWS / BM; nN = NWIN / BM; }
  else { A = (const bf16_t*)(wsb + WS_PROJ) + C_RG; lda = NP; Bt = (const bf16_t*)(wsb + WS_WOUT) + (size_t)layer * 1024 * 2048; ldb = 2048; K = 2048; nM = HROWS / BM; nN = DM / BM; }
#define WAIT_V(n) asm volatile("s_waitcnt vmcnt(" #n ")" ::: "memory")
#define BAR __builtin_amdgcn_s_barrier()
  const int wid = tid >> 6, lane = tid & 63, wr = wid >> 2, wc = wid & 3, fr = lane & 15, fq = lane >> 4;
  constexpr int BK2 = 32, NST = 4;
  const int nt = K / BK2;
  int la0, lb0;
  { const int ob = fr * 64 + fq * 16, sw = ob ^ (((ob >> 9) & 1) << 5); la0 = (wr * 4) * 1024 + sw; lb0 = (wc * 2) * 1024 + sw; }
  Unit u, un;
  bool have = unit_next(0, gridDim.x, blockIdx.x, nM, nN, u), pre = false;
  for (int ui = 0; have; ++ui) {
    const bool have_n = unit_next(ui + 1, gridDim.x, blockIdx.x, nM, nN, un);
    const int brow = u.pm * BM, bcol = u.pn * BM;
    f32x4 acc[2][2][4][2];
#pragma unroll
    for (int a = 0; a < 2; ++a)
#pragma unroll
      for (int b = 0; b < 2; ++b)
#pragma unroll
        for (int m = 0; m < 4; ++m)
#pragma unroll
          for (int n = 0; n < 2; ++n) acc[a][b][m][n] = (f32x4){0.f, 0.f, 0.f, 0.f};
    const bf16_t* gA = (MODE == 0) ? A + (size_t)(brow >> 7) * nt * 4096 : A + (size_t)brow * lda; const bf16_t* gB = Bt + (size_t)(bcol >> 7) * nt * 4096;
#define STAGE_ALL(st, kt) do { int _t = tid; asm volatile("" : "+v"(_t)); unsigned char* _s = shmc + (st) * 32768 + _t * 16; \
      const int _sb = (_t & 63) * 16, _sw = _sb ^ (((_sb >> 9) & 1) << 5), _r = (_t >> 6) * 16 + (_sw >> 6), _c = (_sw & 63) >> 1; \
      const int _oa = _r * lda + _c + (kt) * BK2; \
      _Pragma("unroll") for (int _h = 0; _h < 2; ++_h) { \
        __builtin_amdgcn_global_load_lds((const unsigned*)((MODE == 0) ? gA + ((size_t)_h * nt + (kt)) * 4096 + _t * 8 : gA + (size_t)_h * HALF * lda + _oa), (unsigned*)(_s + _h * 8192), 16, 0, 0); \
        __builtin_amdgcn_global_load_lds((const unsigned*)(gB + ((size_t)_h * nt + (kt)) * 4096 + _t * 8), (unsigned*)(_s + 16384 + _h * 8192), 16, 0, 0); } } while (0)
    if (!pre) { STAGE_ALL(0, 0); STAGE_ALL(1, 1); }
    STAGE_ALL(2, 2);
    for (int kt = 0; kt < nt; ++kt) {
      const int rem = nt - 1 - kt;
      if (rem >= 2) WAIT_V(8); else if (rem == 1) WAIT_V(4); else WAIT_V(0);
      BAR;
      const unsigned char* sb = shmc + (kt & 3) * 32768;
#define LDA_(dst, ai) _Pragma("unroll") for (int m = 0; m < 4; ++m) dst[m] = *(const bf16x8*)(sb + (ai) * 8192 + la0 + m * 1024)
#define LDB_(dst) _Pragma("unroll") for (int bj = 0; bj < 2; ++bj) _Pragma("unroll") for (int n = 0; n < 2; ++n) dst[bj][n] = *(const bf16x8*)(sb + 16384 + bj * 8192 + lb0 + n * 1024)
#define MMA_(ai, bf_, af_) _Pragma("unroll") for (int bj = 0; bj < 2; ++bj) _Pragma("unroll") for (int m = 0; m < 4; ++m) _Pragma("unroll") for (int n = 0; n < 2; ++n) \
        acc[ai][bj][m][n] = __builtin_amdgcn_mfma_f32_16x16x32_bf16(bf_[bj][n], af_[m], acc[ai][bj][m][n], 0, 0, 0)
      {
        bf16x8 b0[2][2], a0[4], a1[4];
        LDB_(b0); LDA_(a0, 0);
        __builtin_amdgcn_sched_barrier(0);
        LDA_(a1, 1); MMA_(0, b0, a0);
        __builtin_amdgcn_sched_barrier(0);
        if (kt + 3 < nt) STAGE_ALL((kt + 3) & 3, kt + 3);
        __builtin_amdgcn_sched_barrier(0);
        MMA_(1, b0, a1);
      }
#undef LDA_
#undef LDB_
#undef MMA_
    }
    __syncthreads();
    pre = false;
    if (pre) {
      gA = A + (size_t)((un.pm * BM) >> 7) * nt * 4096; gB = Bt + (size_t)((un.pn * BM) >> 7) * nt * 4096;
      STAGE_ALL(0, 0); STAGE_ALL(1, 1);
    }
    const int row_b = brow + wr * 64 + fr, col_b = bcol + wc * 32 + fq * 4;
    if (MODE == 0) {
      if (u.pn < 26) {
        bf16_t* proj = (bf16_t*)(wsb + WS_PROJ);
        unsigned char* es = shmc + 65536;
#pragma unroll
        for (int ai = 0; ai < 2; ++ai) {
#pragma unroll
          for (int m = 0; m < 4; ++m) {
            unsigned char* rp = es + (wr * 64 + m * 16 + fr) * 528 + (wc * 32 + fq * 4) * 2;
#pragma unroll
            for (int bj = 0; bj < 2; ++bj)
#pragma unroll
              for (int n = 0; n < 2; ++n) { const f32x4 v = acc[ai][bj][m][n]; uint2 w; w.x = pk2(v[0], v[1]); w.y = pk2(v[2], v[3]); *(uint2*)(rp + (bj * HALF + n * 16) * 2) = w; }
          }
          __syncthreads();
          {
            const int r0 = tid >> 5, ch = tid & 31;
#pragma unroll
            for (int i = 0; i < 8; ++i) {
              const int row = r0 + 16 * i;
              { typedef unsigned u32x4_t __attribute__((ext_vector_type(4))); const u32x4_t v_ = *(const u32x4_t*)(es + row * 528 + ch * 16); __builtin_nontemporal_store(v_, (u32x4_t*)(proj + (size_t)(brow + ai * HALF + row) * NP + bcol + ch * 8)); }
            }
          }
          __syncthreads();
        }
      } else {
        float* tail = (float*)(wsb + WS_TAIL);
        float* sT = (float*)shmc;
        if (wc == 0) {
#pragma unroll
          for (int ai = 0; ai < 2; ++ai)
#pragma unroll
            for (int m = 0; m < 4; ++m)
#pragma unroll
              for (int n = 0; n < 2; ++n) *(f32x4*)(sT + (ai * HALF + wr * 64 + m * 16 + fr) * 36 + n * 16 + fq * 4) = acc[ai][0][m][n];
        }
        __syncthreads();
        float* tp = tail + (size_t)(hf * HROWS + brow) * 24;
#pragma unroll 1
        for (int idx = tid; idx < 256 * 24; idx += NTHR) {
          const int row = idx / 24, col = idx - row * 24;
          const float v = sT[row * 36 + col];
          float r;
          if (col < 16) r = softplus_f(v + p.dt_bias[layer * 16 + col]);
          else r = -softplus_f(-(v + p.b_forget[layer * 8 + col - 16]));
          tp[idx] = r;
        }
        __syncthreads();
      }
    } else {
      const float* xin = (layer == 0) ? p.x : p.out;
      const float* modb = (const float*)(wsb + WS_MOD);
#pragma unroll
      for (int ai = 0; ai < 2; ++ai) {
#pragma unroll
        for (int m = 0; m < 4; ++m) {
          unsigned char* rp = shmc + (wr * 64 + m * 16 + fr) * 1040 + (wc * 32 + fq * 4) * 4;
#pragma unroll
          for (int bj = 0; bj < 2; ++bj)
#pragma unroll
            for (int n = 0; n < 2; ++n) *(f32x4*)(rp + (bj * HALF + n * 16) * 4) = acc[ai][bj][m][n];
        }
        __syncthreads();
        {
          const int r0 = tid >> 6, ch = tid & 63;
          const int growb = hf * HROWS + brow + ai * HALF;
          const float* gate = modb + (size_t)(layer * 4 + (growb >> 13)) * 3072 + 2048 + bcol + ch * 4;
          const float4 g = *(const float4*)gate;
#pragma unroll 4
          for (int i = 0; i < 16; ++i) {
            const int row = r0 + 8 * i;
            const float4 v = *(const float4*)(shmc + row * 1040 + ch * 16);
            const size_t off = (size_t)(growb + row) * DM + bcol + ch * 4;
            const f32x4 xo = __builtin_nontemporal_load((const f32x4*)(xin + off));
            f32x4 o; o[0] = xo[0] + g.x * v.x; o[1] = xo[1] + g.y * v.y; o[2] = xo[2] + g.z * v.z; o[3] = xo[3] + g.w * v.w;
            __builtin_nontemporal_store(o, (f32x4*)(p.out + off));
          }
        }
        __syncthreads();
      }
    }
    u = un; have = have_n;
  }
#undef STAGE_ALL
#undef WAIT_V
#undef BAR
}

DI void conv8(const bf16_t* projb, int t, int ch0, const float* cw, const float* cb, float* o) {
  const float4 b0 = *(const float4*)(cb + ch0), b1 = *(const float4*)(cb + ch0 + 4);
  float a[8] = {b0.x, b0.y, b0.z, b0.w, b1.x, b1.y, b1.z, b1.w};
#pragma unroll
  for (int i = 0; i < 4; ++i) {
    const int tt = t - 3 + i;
    if (tt >= 0) {
      const uint4 raw = *(const uint4*)(projb + (size_t)tt * NP + C_XS + ch0);
      const float4 w0 = *(const float4*)(cw + i * 1536 + ch0), w1 = *(const float4*)(cw + i * 1536 + ch0 + 4);
      float u[8]; unpack8(raw, u);
      a[0] += w0.x * u[0]; a[1] += w0.y * u[1]; a[2] += w0.z * u[2]; a[3] += w0.w * u[3];
      a[4] += w1.x * u[4]; a[5] += w1.y * u[5]; a[6] += w1.z * u[6]; a[7] += w1.w * u[7];
    }
  }
#pragma unroll
  for (int e = 0; e < 8; ++e) o[e] = silu_f(a[e]);
}

constexpr int LD = 136;

DI void wave_cumsum128(float a0, float a1, int lane, float& c0, float& c1, float& last) {
  const float s1 = a0 + a1; float v = s1;
#pragma unroll
  for (int off = 1; off < 64; off <<= 1) { const float t = shup(v, off, lane); if (lane >= off) v += t; }
  const float ex = v - s1; c0 = ex + a0; c1 = ex + s1; last = __int_as_float(__builtin_amdgcn_readlane(__float_as_int(v), 63));
}

DI void ret_local_unit(const Params& p, int hf, int bl, int c, int hd, unsigned char* shm, int tid) {
  unsigned char* wsb = ows(p);
  bf16_t* sK = (bf16_t*)shm; bf16_t* sV = sK + 128 * LD;
  const bf16_t* projb = (const bf16_t*)(wsb + WS_PROJ) + (size_t)bl * SEQ * NP;
  const float2* cs = (const float2*)(wsb + WS_CS) + (size_t)((hf * 2 + bl) * SEQ + c * 128) * 64;
  const float lg = logf(1.0f - ex2(-5.0f - (float)hd));
#pragma unroll
  for (int it = 0; it < 2; ++it) {
    const int idx = tid + it * NTHR, j = idx >> 3, dg = idx & 7;
    const bf16_t* base = projb + (size_t)(c * 128 + j) * NP;
    float k1[8], k2[8]; unpack8(*(const uint4*)(base + C_RK + hd * 128 + dg * 8), k1); unpack8(*(const uint4*)(base + C_RK + hd * 128 + 64 + dg * 8), k2);
    const float w = __expf(lg * (float)(127 - j)) * 0.08838834764831845f;
    float o1[8], o2[8];
#pragma unroll
    for (int e = 0; e < 8; ++e) {
      const float2 t = cs[j * 64 + dg * 8 + e];
      o1[e] = (k1[e] * t.x - k2[e] * t.y) * w; o2[e] = (k1[e] * t.y + k2[e] * t.x) * w;
    }
    *(uint4*)(sK + j * LD + dg * 8) = pack8(o1); *(uint4*)(sK + j * LD + 64 + dg * 8) = pack8(o2);
    *(uint4*)(sV + j * LD + dg * 16) = *(const uint4*)(base + C_RV + hd * 128 + dg * 16);
    *(uint4*)(sV + j * LD + dg * 16 + 8) = *(const uint4*)(base + C_RV + hd * 128 + dg * 16 + 8);
  }
  __syncthreads();
  const int wid = tid >> 6, lane = tid & 63, fr = lane & 15, fq = lane >> 4;
  f32x4 acc[8];
#pragma unroll
  for (int n = 0; n < 8; ++n) acc[n] = (f32x4){0.f, 0.f, 0.f, 0.f};
#pragma unroll
  for (int ks = 0; ks < 4; ++ks) {
    const bf16x8 a = frag_tr(sV, LD, 32 * ks, 16 * wid, fr, fq);
#pragma unroll
    for (int n = 0; n < 8; ++n) acc[n] = mmaT(a, frag_tr(sK, LD, 32 * ks, 16 * n, fr, fq), acc[n]);
  }
  bf16_t* st = (bf16_t*)(wsb + WS_RST) + (size_t)((bl * 64 + c) * 4 + hd) * 16384;
#pragma unroll
  for (int n = 0; n < 8; ++n) { uint2 w; w.x = pk2(acc[n][0], acc[n][1]); w.y = pk2(acc[n][2], acc[n][3]); *(uint2*)(st + (16 * wid + fr) * 128 + 16 * n + 4 * fq) = w; }
  __syncthreads();
}

#define CONV_RUN8(projb, t0, ch0, cw, cb, EMIT) do { \
    float w_[4][8], b_[8], win_[3][8]; \
    { const float4 x0 = *(const float4*)((cb) + (ch0)), x1 = *(const float4*)((cb) + (ch0) + 4); b_[0] = x0.x; b_[1] = x0.y; b_[2] = x0.z; b_[3] = x0.w; b_[4] = x1.x; b_[5] = x1.y; b_[6] = x1.z; b_[7] = x1.w; } \
    _Pragma("unroll") for (int i_ = 0; i_ < 4; ++i_) { const float4 x0 = *(const float4*)((cw) + i_ * 1536 + (ch0)), x1 = *(const float4*)((cw) + i_ * 1536 + (ch0) + 4); \
      w_[i_][0] = x0.x; w_[i_][1] = x0.y; w_[i_][2] = x0.z; w_[i_][3] = x0.w; w_[i_][4] = x1.x; w_[i_][5] = x1.y; w_[i_][6] = x1.z; w_[i_][7] = x1.w; } \
    uint4 raw_[11]; \
    _Pragma("unroll") for (int i_ = 0; i_ < 11; ++i_) { const int tt_ = (t0) - 3 + i_; raw_[i_] = (tt_ >= 0) ? *(const uint4*)((projb) + (size_t)tt_ * NP + C_XS + (ch0)) : make_uint4(0u, 0u, 0u, 0u); } \
    _Pragma("unroll") for (int i_ = 0; i_ < 3; ++i_) unpack8(raw_[i_], win_[i_]); \
    _Pragma("unroll") for (int r_ = 0; r_ < 8; ++r_) { float cur_[8], o_[8]; unpack8(raw_[3 + r_], cur_); \
      _Pragma("unroll") for (int e_ = 0; e_ < 8; ++e_) { o_[e_] = silu_f(b_[e_] + w_[0][e_] * win_[0][e_] + w_[1][e_] * win_[1][e_] + w_[2][e_] * win_[2][e_] + w_[3][e_] * cur_[e_]); \
        win_[0][e_] = win_[1][e_]; win_[1][e_] = win_[2][e_]; win_[2][e_] = cur_[e_]; } \
      EMIT(r_, o_); } } while (0)

DI void ssd_local_unit(const Params& p, int layer, int hf, int bl, int c, int g, unsigned char* shm, int tid) {
  unsigned char* wsb = ows(p);
  constexpr int LX = 264;
  bf16_t* sB = (bf16_t*)shm; bf16_t* sX = sB + 128 * LD;
  float* sW = (float*)(sX + 128 * LX);
  const bf16_t* projb = (const bf16_t*)(wsb + WS_PROJ) + (size_t)bl * SEQ * NP;
  bf16_t* xcb = (bf16_t*)(wsb + WS_XC) + (size_t)(bl * SEQ) * 1536;
  const float* tail = (const float*)(wsb + WS_TAIL) + (size_t)((hf * 2 + bl) * SEQ + c * 128) * 24;
  const float* cw = p.conv_w + (size_t)layer * 4 * 1536; const float* cb = p.conv_b + layer * 1536;
  const int wid = tid >> 6, lane = tid & 63, fr = lane & 15, fq = lane >> 4;
  {
    const int h = g * 8 + wid; const float Ah = -__expf(p.a_log[layer * 16 + h]);
    const float d0 = tail[(2 * lane) * 24 + h], d1 = tail[(2 * lane + 1) * 24 + h];
    float c0, c1, last; wave_cumsum128(d0 * Ah, d1 * Ah, lane, c0, c1, last);
    sW[wid * 128 + 2 * lane] = d0 * __expf(last - c0); sW[wid * 128 + 2 * lane + 1] = d1 * __expf(last - c1);
    if (lane == 0) ((float*)(wsb + WS_ASUM))[(bl * 64 + c) * 16 + h] = last;
  }
  const int cgi = tid & 31, trg = tid >> 5, t0 = c * 128 + trg * 8;
  {
    const int ch0 = (cgi < 16) ? (1024 + g * 128 + cgi * 8) : (1280 + g * 128 + (cgi - 16) * 8);
#define EMIT_BC(r, o) do { const uint4 pk_ = pack8(o); *(uint4*)(xcb + (size_t)(t0 + (r)) * 1536 + ch0) = pk_; if (cgi < 16) *(uint4*)(sB + (trg * 8 + (r)) * LD + cgi * 8) = pk_; } while (0)
    CONV_RUN8(projb, t0, ch0, cw, cb, EMIT_BC);
#undef EMIT_BC
  }
  __syncthreads();
  for (int hb = 0; hb < 2; ++hb) {
    {
      const int hq = cgi >> 3, ch0 = (g * 8 + hb * 4) * 64 + cgi * 8;
#define EMIT_X(r, o) do { *(uint4*)(xcb + (size_t)(t0 + (r)) * 1536 + ch0) = pack8(o); const float w__ = sW[(hb * 4 + hq) * 128 + trg * 8 + (r)]; \
        float s__[8]; _Pragma("unroll") for (int e__ = 0; e__ < 8; ++e__) s__[e__] = (o)[e__] * w__; *(uint4*)(sX + (trg * 8 + (r)) * LX + cgi * 8) = pack8(s__); } while (0)
      CONV_RUN8(projb, t0, ch0, cw, cb, EMIT_X);
#undef EMIT_X
    }
    __syncthreads();
    const int hq = wid >> 1, nh = wid & 1;
    f32x4 acc[4][4];
#pragma unroll
    for (int m = 0; m < 4; ++m)
#pragma unroll
      for (int n = 0; n < 4; ++n) acc[m][n] = (f32x4){0.f, 0.f, 0.f, 0.f};
#pragma unroll
    for (int ks = 0; ks < 4; ++ks) {
      bf16x8 bfr[4];
#pragma unroll
      for (int n = 0; n < 4; ++n) bfr[n] = frag_tr(sB, LD, 32 * ks, nh * 64 + 16 * n, fr, fq);
#pragma unroll
      for (int m = 0; m < 4; ++m) {
        const bf16x8 a = frag_tr(sX, LX, 32 * ks, hq * 64 + 16 * m, fr, fq);
#pragma unroll
        for (int n = 0; n < 4; ++n) acc[m][n] = mmaT(a, bfr[n], acc[m][n]);
      }
    }
    float* st = (float*)(wsb + WS_SST) + (size_t)((bl * 64 + c) * 16 + g * 8 + hb * 4 + hq) * 8192;
#pragma unroll
    for (int m = 0; m < 4; ++m)
#pragma unroll
      for (int n = 0; n < 4; ++n) *(f32x4*)(st + (16 * m + fr) * 128 + nh * 64 + 16 * n + 4 * fq) = acc[m][n];
    __syncthreads();
  }
}

DI void fox_cumsum_unit(const Params& p, int hf, int bl, int fh, unsigned char* shm, int tid) {
  unsigned char* wsb = ows(p);
  float* sWv = (float*)shm;
  float* base = (float*)(wsb + WS_TAIL) + (size_t)((hf * 2 + bl) * SEQ) * 24 + 16 + fh;
  const int wid = tid >> 6, lane = tid & 63;
  float v[16];
#pragma unroll
  for (int e = 0; e < 16; ++e) v[e] = base[(size_t)(tid * 16 + e) * 24];
#pragma unroll
  for (int e = 1; e < 16; ++e) v[e] += v[e - 1];
  const float tot = v[15]; float inc = tot;
#pragma unroll
  for (int off = 1; off < 64; off <<= 1) { const float t = shup(inc, off, lane); if (lane >= off) inc += t; }
  if (lane == 63) sWv[wid] = inc;
  __syncthreads();
  float woff = 0.f;
  for (int i = 0; i < wid; ++i) woff += sWv[i];
  const float ex = woff + inc - tot;
  { float* fc = (float*)(wsb + WS_FC) + (size_t)(bl * 8 + fh) * SEQ + tid * 16;
#pragma unroll
    for (int e = 0; e < 16; e += 4) { float4 w4; w4.x = v[e] + ex; w4.y = v[e + 1] + ex; w4.z = v[e + 2] + ex; w4.w = v[e + 3] + ex; *(float4*)(fc + e) = w4; } }
  const bf16_t* kb = (const bf16_t*)(wsb + WS_PROJ) + (size_t)(bl * SEQ + tid * 16) * NP + C_FK + fh * 64;
  float kmx = 0.f;
#pragma unroll 4
  for (int e = 0; e < 16; ++e) {
    float ssum = 0.f;
#pragma unroll
    for (int q = 0; q < 8; ++q) { float f[8]; unpack8(*(const uint4*)(kb + (size_t)e * NP + q * 8), f);
#pragma unroll
      for (int z = 0; z < 8; ++z) ssum += f[z] * f[z]; }
    kmx = fmaxf(kmx, ssum);
  }
#pragma unroll
  for (int o = 32; o >= 1; o >>= 1) kmx = fmaxf(kmx, shx(kmx, o, lane));
  __syncthreads();
  if (lane == 0) sWv[16 + wid] = kmx;
  __syncthreads();
  if (tid == 0) { float m = 0.f; for (int i = 0; i < 8; ++i) m = fmaxf(m, sWv[16 + i]); ((float*)(wsb + WS_KMAX))[bl * 8 + fh] = m; }
  __syncthreads();
}

DI void scan_unit(const Params& p, int hf, int su, int tid) {
  unsigned char* wsb = ows(p);
  const int gtid = su * NTHR + tid, gn = 1 << 30;
  bf16_t* rst = (bf16_t*)(wsb + WS_RST); float* sst = (float*)(wsb + WS_SST); const float* asum = (const float*)(wsb + WS_ASUM);
  const int n_r = 2 * 4 * 4096, n_s = 2 * 16 * 2048;
  for (int i = gtid; i < n_r + n_s; i += gn) {
    if (i < n_r) {
      float S0 = 0.f, S1 = 0.f, S2 = 0.f, S3 = 0.f;
      const int bl = i / 16384, hd = (i / 4096) & 3, e = (i & 4095) * 4;
      const float dc = __expf(logf(1.0f - ex2(-5.0f - (float)hd)) * 128.0f);
      bf16_t* ptr = rst + (size_t)(bl * 64 * 4 + hd) * 16384 + e;
#pragma unroll 8
      for (int c = 0; c < 64; ++c) {
        uint2* q = (uint2*)(ptr + (size_t)c * 4 * 16384); const uint2 v = *q;
        uint2 w; w.x = pk2(S0, S1); w.y = pk2(S2, S3); *q = w;
        S0 = S0 * dc + bflo(v.x); S1 = S1 * dc + bfhi(v.x); S2 = S2 * dc + bflo(v.y); S3 = S3 * dc + bfhi(v.y);
      }
    } else {
      const int k = i - n_r, bl = k / 32768, h = (k / 2048) & 15, e = (k & 2047) * 4;
      float S0 = 0.f, S1 = 0.f, S2 = 0.f, S3 = 0.f;
      const float* ptr = sst + (size_t)(bl * 64 * 16 + h) * 8192 + e;
      bf16_t* pp = (bf16_t*)(wsb + WS_SSTP + (size_t)hf * HROWS * DM * 2) + (size_t)(bl * 64 * 16 + h) * 8192 + e;
#pragma unroll 8
      for (int c = 0; c < 64; ++c) {
        const float4 lo = *(const float4*)(ptr + (size_t)c * 16 * 8192);
        uint2 w; w.x = pk2(S0, S1); w.y = pk2(S2, S3); *(uint2*)(pp + (size_t)c * 16 * 8192) = w;
        const float dc = __expf(asum[(bl * 64 + c) * 16 + h]);
        S0 = S0 * dc + lo.x; S1 = S1 * dc + lo.y; S2 = S2 * dc + lo.z; S3 = S3 * dc + lo.w;
      }
    }
  }
}

DI void ret_out_unit(const Params& p, int hf, int bl, int c, int hd, unsigned char* shm, int tid, bool dry = false) {
  unsigned char* wsb = ows(p);
  bf16_t* sQ = (bf16_t*)shm; bf16_t* sK = sQ + 128 * LD; bf16_t* sVt = sK + 128 * LD; bf16_t* sS = sVt + 128 * LD;
  bf16_t* projb = (bf16_t*)(wsb + WS_PROJ) + (size_t)bl * SEQ * NP;
  const float2* cs = (const float2*)(wsb + WS_CS) + (size_t)((hf * 2 + bl) * SEQ + c * 128) * 64;
  const float lg = logf(1.0f - ex2(-5.0f - (float)hd));
#pragma unroll
  for (int it = 0; it < 2; ++it) {
    const int idx = tid + it * NTHR, j = idx >> 3, dg = idx & 7;
    const bf16_t* base = projb + (size_t)(c * 128 + j) * NP;
    float q1[8], q2[8], k1[8], k2[8];
    unpack8(*(const uint4*)(base + C_RQ + hd * 128 + dg * 8), q1); unpack8(*(const uint4*)(base + C_RQ + hd * 128 + 64 + dg * 8), q2);
    unpack8(*(const uint4*)(base + C_RK + hd * 128 + dg * 8), k1); unpack8(*(const uint4*)(base + C_RK + hd * 128 + 64 + dg * 8), k2);
    float oq1[8], oq2[8], ok1[8], ok2[8];
#pragma unroll
    for (int e = 0; e < 8; ++e) {
      const float2 t = cs[j * 64 + dg * 8 + e];
      oq1[e] = q1[e] * t.x - q2[e] * t.y; oq2[e] = q1[e] * t.y + q2[e] * t.x;
      ok1[e] = (k1[e] * t.x - k2[e] * t.y) * 0.08838834764831845f; ok2[e] = (k1[e] * t.y + k2[e] * t.x) * 0.08838834764831845f;
    }
    *(uint4*)(sQ + j * LD + dg * 8) = pack8(oq1); *(uint4*)(sQ + j * LD + 64 + dg * 8) = pack8(oq2);
    *(uint4*)(sK + j * LD + dg * 8) = pack8(ok1); *(uint4*)(sK + j * LD + 64 + dg * 8) = pack8(ok2);
    *(uint4*)(sVt + j * LD + dg * 16) = *(const uint4*)(base + C_RV + hd * 128 + dg * 16);
    *(uint4*)(sVt + j * LD + dg * 16 + 8) = *(const uint4*)(base + C_RV + hd * 128 + dg * 16 + 8);
  }
  __syncthreads();
  const int wid = tid >> 6, lane = tid & 63, fr = lane & 15, fq = lane >> 4;
  const int i_row = 16 * wid + fr;
  uint4 stv0, stv1, stv2, stv3; uint2 gv8[8];
  {
    const bf16_t* st = (const bf16_t*)(wsb + WS_RST) + (size_t)((bl * 64 + c) * 4 + hd) * 16384;
    { const int e0 = tid >> 3, dg = tid & 7; stv0 = *(const uint4*)(st + e0 * 128 + dg * 16); stv1 = *(const uint4*)(st + e0 * 128 + dg * 16 + 8); stv2 = *(const uint4*)(st + (e0 + 64) * 128 + dg * 16); stv3 = *(const uint4*)(st + (e0 + 64) * 128 + dg * 16 + 8); }
    const bf16_t* gp0 = projb + (size_t)(c * 128 + i_row) * NP + C_RG + hd * 128 + 4 * fq;
#pragma unroll
    for (int n = 0; n < 8; ++n) gv8[n] = *(const uint2*)(gp0 + 16 * n);
  }
  {
    bf16x8 aq[4];
#pragma unroll
    for (int ks = 0; ks < 4; ++ks) aq[ks] = ldf(sQ, LD, 16 * wid, 32 * ks, fr, fq);
#pragma unroll
    for (int n = 0; n < 8; ++n) {
      if (n <= (wid | 1)) {
        uint2 w; w.x = 0u; w.y = 0u;
        if (n <= wid) {
          f32x4 s = (f32x4){0.f, 0.f, 0.f, 0.f};
#pragma unroll
          for (int ks = 0; ks < 4; ++ks) s = mmaT(aq[ks], ldf(sK, LD, 16 * n, 32 * ks, fr, fq), s);
          float r[4];
#pragma unroll
          for (int j = 0; j < 4; ++j) { const int d = i_row - (16 * n + 4 * fq + j); r[j] = (d >= 0) ? s[j] * __expf(lg * (float)d) : 0.f; }
          w.x = pk2(r[0], r[1]); w.y = pk2(r[2], r[3]);
        }
        *(uint2*)(sS + i_row * LD + 16 * n + 4 * fq) = w;
      }
    }
  }
  f32x4 o1[8];
#pragma unroll
  for (int n = 0; n < 8; ++n) o1[n] = (f32x4){0.f, 0.f, 0.f, 0.f};
  const int nks = (wid >> 1) + 1;
  for (int ks = 0; ks < nks; ++ks) {
    const bf16x8 a = ldf(sS, LD, 16 * wid, 32 * ks, fr, fq);
#pragma unroll
    for (int n = 0; n < 8; ++n) o1[n] = mmaT(a, frag_tr(sVt, LD, 32 * ks, 16 * n, fr, fq), o1[n]);
  }
  __syncthreads();
  {
    { const int e0 = tid >> 3, dg = tid & 7;
      *(uint4*)(sK + e0 * LD + dg * 16) = stv0; *(uint4*)(sK + e0 * LD + dg * 16 + 8) = stv1;
      *(uint4*)(sK + (e0 + 64) * LD + dg * 16) = stv2; *(uint4*)(sK + (e0 + 64) * LD + dg * 16 + 8) = stv3; }
  }
  __syncthreads();
  f32x4 o2[8];
#pragma unroll
  for (int n = 0; n < 8; ++n) o2[n] = (f32x4){0.f, 0.f, 0.f, 0.f};
#pragma unroll
  for (int ks = 0; ks < 4; ++ks) {
    const bf16x8 a = ldf(sQ, LD, 16 * wid, 32 * ks, fr, fq);
#pragma unroll
    for (int n = 0; n < 8; ++n) o2[n] = mmaT(a, ldf(sK, LD, 16 * n, 32 * ks, fr, fq), o2[n]);
  }
  const float dq = __expf(lg * (float)(i_row + 1));
  float ss = 0.f;
#pragma unroll
  for (int n = 0; n < 8; ++n)
#pragma unroll
    for (int j = 0; j < 4; ++j) { const float v = o1[n][j] + o2[n][j] * dq; o1[n][j] = v; ss += v * v; }
  ss += shx(ss, 16, lane); ss += shx(ss, 32, lane);
  const float rinv = rsqrtf(ss * (1.0f / 128.0f) + EPS);
  bf16_t* gp = projb + (size_t)(c * 128 + i_row) * NP + C_RG + hd * 128 + 4 * fq;
#pragma unroll
  for (int n = 0; n < 8; ++n) {
    const uint2 gv = gv8[n];
    uint2 w;
    w.x = pk2(o1[n][0] * rinv * silu_f(bflo(gv.x)), o1[n][1] * rinv * silu_f(bfhi(gv.x)));
    w.y = pk2(o1[n][2] * rinv * silu_f(bflo(gv.y)), o1[n][3] * rinv * silu_f(bfhi(gv.y)));
    if (!dry || rinv == 1.2345e-30f) *(uint2*)(gp + 16 * n) = w;
  }
  __syncthreads();
}

DI void ssd_out_unit(const Params& p, int layer, int hf, int bl, int c, unsigned char* shm, int tid, bool dry = false) {
  unsigned char* wsb = ows(p);
  constexpr int LXS = 72;
  bf16_t* sC = (bf16_t*)shm; bf16_t* sB = sC + 128 * LD; bf16_t* sM = sB; bf16_t* sX = sB + 128 * LD; bf16_t* sSp = sX + 128 * LXS;
  float* sDt = (float*)(sSp + 64 * LD); float* sAc = sDt + 16 * 128;
  bf16_t* projb = (bf16_t*)(wsb + WS_PROJ) + (size_t)bl * SEQ * NP;
  const bf16_t* xcb = (const bf16_t*)(wsb + WS_XC) + (size_t)(bl * SEQ + c * 128) * 1536;
  const float* tail = (const float*)(wsb + WS_TAIL) + (size_t)((hf * 2 + bl) * SEQ + c * 128) * 24;
  const int wid = tid >> 6, lane = tid & 63, fr = lane & 15, fq = lane >> 4;
  const int i_row = 16 * wid + fr;
#pragma unroll
  for (int q = 0; q < 2; ++q) {
    const int h = 2 * wid + q; const float Ah = -__expf(p.a_log[layer * 16 + h]);
    const float d0 = tail[(2 * lane) * 24 + h], d1 = tail[(2 * lane + 1) * 24 + h];
    float c0, c1, last; wave_cumsum128(d0 * Ah, d1 * Ah, lane, c0, c1, last);
    sDt[h * 128 + 2 * lane] = d0; sDt[h * 128 + 2 * lane + 1] = d1; sAc[h * 128 + 2 * lane] = c0; sAc[h * 128 + 2 * lane + 1] = c1;
  }
  float ssq = 0.f;
  for (int g = 0; g < 2; ++g) {
    __syncthreads();
#pragma unroll
    for (int it = 0; it < 4; ++it) {
      const int idx = tid + it * NTHR, j = idx >> 4, ng = idx & 15;
      *(uint4*)(sC + j * LD + ng * 8) = *(const uint4*)(xcb + (size_t)j * 1536 + 1280 + g * 128 + ng * 8);
      *(uint4*)(sB + j * LD + ng * 8) = *(const uint4*)(xcb + (size_t)j * 1536 + 1024 + g * 128 + ng * 8);
    }
    __syncthreads();
    f32x4 cbv[8];
    {
      bf16x8 ac[4];
#pragma unroll
      for (int ks = 0; ks < 4; ++ks) ac[ks] = ldf(sC, LD, 16 * wid, 32 * ks, fr, fq);
#pragma unroll
      for (int n = 0; n < 8; ++n) {
        cbv[n] = (f32x4){0.f, 0.f, 0.f, 0.f};
        if (n <= wid) {
#pragma unroll
          for (int ks = 0; ks < 4; ++ks) cbv[n] = mmaT(ac[ks], ldf(sB, LD, 16 * n, 32 * ks, fr, fq), cbv[n]);
        }
      }
    }
    __syncthreads();
    uint4 xr0, xr1, sr0, sr1;
    const int xj0 = tid >> 3, xpg = tid & 7;
    {
      const int h0 = g * 8;
      xr0 = *(const uint4*)(xcb + (size_t)xj0 * 1536 + h0 * 64 + xpg * 8); xr1 = *(const uint4*)(xcb + (size_t)(xj0 + 64) * 1536 + h0 * 64 + xpg * 8);
      const bf16_t* st = (const bf16_t*)(wsb + WS_SSTP + (size_t)hf * HROWS * DM * 2) + (size_t)((bl * 64 + c) * 16 + h0) * 8192 + xj0 * 128 + xpg * 16;
      sr0 = *(const uint4*)(st); sr1 = *(const uint4*)(st + 8);
    }
    for (int hh = 0; hh < 8; ++hh) {
      const int h = g * 8 + hh;
      *(uint4*)(sX + xj0 * LXS + xpg * 8) = xr0; *(uint4*)(sX + (xj0 + 64) * LXS + xpg * 8) = xr1;
      *(uint4*)(sSp + xj0 * LD + xpg * 16) = sr0; *(uint4*)(sSp + xj0 * LD + xpg * 16 + 8) = sr1;
      {
        const int h1 = (hh + 1 < 8) ? h + 1 : h;
        xr0 = *(const uint4*)(xcb + (size_t)xj0 * 1536 + h1 * 64 + xpg * 8); xr1 = *(const uint4*)(xcb + (size_t)(xj0 + 64) * 1536 + h1 * 64 + xpg * 8);
        const bf16_t* st = (const bf16_t*)(wsb + WS_SSTP + (size_t)hf * HROWS * DM * 2) + (size_t)((bl * 64 + c) * 16 + h1) * 8192 + xj0 * 128 + xpg * 16;
        sr0 = *(const uint4*)(st); sr1 = *(const uint4*)(st + 8);
      }
      const float ac_i = sAc[h * 128 + i_row];
#pragma unroll
      for (int n = 0; n < 8; ++n) {
        if (n <= (wid | 1)) {
          uint2 w; w.x = 0u; w.y = 0u;
          if (n <= wid) {
            const float4 acj = *(const float4*)(sAc + h * 128 + 16 * n + 4 * fq), dtj = *(const float4*)(sDt + h * 128 + 16 * n + 4 * fq);
            const int j0 = 16 * n + 4 * fq;
            const float r0 = (j0 + 0 <= i_row) ? cbv[n][0] * __expf(ac_i - acj.x) * dtj.x : 0.f;
            const float r1 = (j0 + 1 <= i_row) ? cbv[n][1] * __expf(ac_i - acj.y) * dtj.y : 0.f;
            const float r2 = (j0 + 2 <= i_row) ? cbv[n][2] * __expf(ac_i - acj.z) * dtj.z : 0.f;
            const float r3 = (j0 + 3 <= i_row) ? cbv[n][3] * __expf(ac_i - acj.w) * dtj.w : 0.f;
            w.x = pk2(r0, r1); w.y = pk2(r2, r3);
          }
          *(uint2*)(sM + i_row * LD + 16 * n + 4 * fq) = w;
        }
      }
      bf16_t* zp = projb + (size_t)(c * 128 + i_row) * NP + C_Z + h * 64 + 4 * fq;
      uint2 zv4[4];
#pragma unroll
      for (int m = 0; m < 4; ++m) zv4[m] = *(const uint2*)(zp + 16 * m);
      __syncthreads();
      f32x4 y[4], y2[4];
#pragma unroll
      for (int m = 0; m < 4; ++m) { y[m] = (f32x4){0.f, 0.f, 0.f, 0.f}; y2[m] = (f32x4){0.f, 0.f, 0.f, 0.f}; }
      const int nks = (wid >> 1) + 1;
      for (int ks = 0; ks < nks; ++ks) {
        const bf16x8 a = ldf(sM, LD, 16 * wid, 32 * ks, fr, fq);
#pragma unroll
        for (int m = 0; m < 4; ++m) y[m] = mmaT(a, frag_tr(sX, LXS, 32 * ks, 16 * m, fr, fq), y[m]);
      }
#pragma unroll
      for (int ks = 0; ks < 4; ++ks) {
        const bf16x8 a = ldf(sC, LD, 16 * wid, 32 * ks, fr, fq);
#pragma unroll
        for (int m = 0; m < 4; ++m) y2[m] = mmaT(a, ldf(sSp, LD, 16 * m, 32 * ks, fr, fq), y2[m]);
      }
      const float ei = __expf(ac_i), Dh = p.d_skip[layer * 16 + h];
#pragma unroll
      for (int m = 0; m < 4; ++m) {
        const uint2 zv = zv4[m];
        const uint2 xv = *(const uint2*)(sX + i_row * LXS + 16 * m + 4 * fq);
        const float zz[4] = {bflo(zv.x), bfhi(zv.x), bflo(zv.y), bfhi(zv.y)};
        const float xs[4] = {bflo(xv.x), bfhi(xv.x), bflo(xv.y), bfhi(xv.y)};
        float r[4];
#pragma unroll
        for (int j = 0; j < 4; ++j) {
          const float v = (y[m][j] + ei * y2[m][j] + Dh * xs[j]) * silu_f(zz[j]);
          r[j] = v; ssq += v * v;
        }
        uint2 w; w.x = pk2(r[0], r[1]); w.y = pk2(r[2], r[3]);
        if (!dry || ssq == 1.2345e-30f) *(uint2*)(zp + 16 * m) = w;
      }
      __syncthreads();
    }
  }
  ssq += shx(ssq, 16, lane); ssq += shx(ssq, 32, lane);
  const float rinv = rsqrtf(ssq * (1.0f / 1024.0f) + EPS);
  const float* gn = p.ssd_norm_g + layer * 1024;
  bf16_t* zr = projb + (size_t)(c * 128 + i_row) * NP + C_Z + 4 * fq;
  for (int t0 = 0; t0 < 64; t0 += 8) {
    uint2 v8[8]; float4 g8[8];
#pragma unroll
    for (int q = 0; q < 8; ++q) { v8[q] = *(const uint2*)(zr + 16 * (t0 + q)); g8[q] = *(const float4*)(gn + 16 * (t0 + q) + 4 * fq); }
#pragma unroll
    for (int q = 0; q < 8; ++q) {
      uint2 w; w.x = pk2(bflo(v8[q].x) * rinv * g8[q].x, bfhi(v8[q].x) * rinv * g8[q].y); w.y = pk2(bflo(v8[q].y) * rinv * g8[q].z, bfhi(v8[q].y) * rinv * g8[q].w);
      *(uint2*)(zr + 16 * (t0 + q)) = w;
    }
  }
  __syncthreads();
}

template <bool DIAG>
DI void fox_tile(const bf16_t* sK, const bf16_t* sV, const float* sFk, const bf16x8 (&qf)[2][2], f32x4 (&o)[2][4], float (&mrun)[2], float (&lsum)[2], int key0, int qg0, int fr, int fq, int lane) {
  const float SC2 = 0.125f * LOG2E;
  f32x4 s[2][4];
  const int kof = (fr * 64 + fq * 16) ^ ((fr >> 3) << 5);
#pragma unroll
  for (int t = 0; t < 4; ++t) {
    const bf16x8 k0 = *(const bf16x8*)((const unsigned char*)sK + (t * 2) * 1024 + kof), k1 = *(const bf16x8*)((const unsigned char*)sK + (t * 2 + 1) * 1024 + kof);
#pragma unroll
    for (int mi = 0; mi < 2; ++mi) { s[mi][t] = mmaT(qf[mi][0], k0, (f32x4){0.f, 0.f, 0.f, 0.f}); s[mi][t] = mmaT(qf[mi][1], k1, s[mi][t]); }
  }
  f32x4 fk[4];
#pragma unroll
  for (int t = 0; t < 4; ++t) fk[t] = *(const f32x4*)(sFk + 16 * t + 4 * fq);
  __builtin_amdgcn_sched_barrier(0);
  bf16x8 vf[2][4];
#pragma unroll
  for (int k2 = 0; k2 < 2; ++k2)
#pragma unroll
    for (int d = 0; d < 4; ++d) {
      const bf16_t* a = sV + (32 * k2 + 4 * fq + (fr >> 2)) * 72 + 16 * d + 4 * (fr & 3);
      const v4i16_t lo = tr_rd(a), hi = tr_rd(a + 16 * 72);
      vf[k2][d] = __builtin_shufflevector(lo, hi, 0, 1, 2, 3, 4, 5, 6, 7);
    }
  __builtin_amdgcn_sched_barrier(0);
#pragma unroll
  for (int mi = 0; mi < 2; ++mi) {
    float mx = -INFINITY;
#pragma unroll
    for (int t = 0; t < 4; ++t)
#pragma unroll
      for (int j = 0; j < 4; ++j) {
        float x = __builtin_fmaf(s[mi][t][j], SC2, fk[t][j]);
        if (DIAG) { if (key0 + 16 * t + 4 * fq + j > qg0 + 16 * mi) x = -INFINITY; }
        s[mi][t][j] = x; mx = fmaxf(mx, x);
      }
    mx = fmaxf(mx, shx(mx, 16, lane)); mx = fmaxf(mx, shx(mx, 32, lane));
    const float mnew = fmaxf(mrun[mi], mx), alpha = ex2(mrun[mi] - mnew);
    mrun[mi] = mnew;
    float ps = 0.f;
#pragma unroll
    for (int t = 0; t < 4; ++t)
#pragma unroll
      for (int j = 0; j < 4; ++j) { const float pv = ex2(s[mi][t][j] - mnew); s[mi][t][j] = pv; ps += pv; }
    lsum[mi] = lsum[mi] * alpha + ps;
#pragma unroll
    for (int d = 0; d < 4; ++d) o[mi][d] *= alpha;
  }
#pragma unroll
  for (int k2 = 0; k2 < 2; ++k2) {
    bf16x8 pa[2];
#pragma unroll
    for (int mi = 0; mi < 2; ++mi) pa[mi] = mk8(pk2(s[mi][2 * k2][0], s[mi][2 * k2][1]), pk2(s[mi][2 * k2][2], s[mi][2 * k2][3]), pk2(s[mi][2 * k2 + 1][0], s[mi][2 * k2 + 1][1]), pk2(s[mi][2 * k2 + 1][2], s[mi][2 * k2 + 1][3]));
#pragma unroll
    for (int d = 0; d < 4; ++d) {
#pragma unroll
      for (int mi = 0; mi < 2; ++mi) o[mi][d] = mmaT(pa[mi], vf[k2][d], o[mi][d]);
    }
  }
}

DI void fox_unit(const Params& p, int hf, int bl, int fh, int qb, unsigned char* shm, int tid, bool dry = false) {
  unsigned char* wsb = ows(p);
  constexpr int STG = 64 * 72 * 2 * 2 + 256;
  bf16_t* projb = (bf16_t*)(wsb + WS_PROJ) + (size_t)bl * SEQ * NP;
  const float* F = (const float*)(wsb + WS_FC) + (size_t)(bl * 8 + fh) * SEQ;
  const int wid = tid >> 6, lane = tid & 63, fr = lane & 15, fq = lane >> 4;
  const int q0 = qb * 256, qg0 = q0 + wid * 32 + fr;
  bf16x8 qf[2][2];
#pragma unroll
  for (int mi = 0; mi < 2; ++mi)
#pragma unroll
    for (int ks = 0; ks < 2; ++ks) {
      const uint4 raw = *(const uint4*)(projb + (size_t)(qg0 + 16 * mi) * NP + C_FQ + fh * 64 + ks * 32 + fq * 8);
      qf[mi][ks] = __builtin_bit_cast(bf16x8, raw);
    }
  float qmax2 = 0.f;
#pragma unroll
  for (int mi = 0; mi < 2; ++mi) {
    float ssum = 0.f;
#pragma unroll
    for (int ks = 0; ks < 2; ++ks) { float f[8]; unpack8(__builtin_bit_cast(uint4, qf[mi][ks]), f);
#pragma unroll
      for (int z = 0; z < 8; ++z) ssum += f[z] * f[z]; }
    ssum += shx(ssum, 16, lane); ssum += shx(ssum, 32, lane);
    qmax2 = fmaxf(qmax2, ssum);
  }
#pragma unroll
  for (int o_ = 8; o_ >= 1; o_ >>= 1) qmax2 = fmaxf(qmax2, shx(qmax2, o_, lane));
  float* sRed = (float*)(shm + 2 * STG);
  if (lane == 0) sRed[wid] = qmax2;
  const float Fref = F[q0];
  __syncthreads();
  float qm2 = 0.f;
#pragma unroll
  for (int i = 0; i < 8; ++i) qm2 = fmaxf(qm2, sRed[i]);
  const float kmax2 = ((const float*)(wsb + WS_KMAX))[bl * 8 + fh];
  const float thr = -110.0f - 0.25f * sqrtf(qm2 * kmax2) * 1.02f;
  const int nkt = 4 * qb + 4;
  int skip = 0;
  if (tid < 4 * qb) skip = (Fref - F[tid * 64 + 63] < thr) ? 1 : 0;
  const unsigned long long bal = __builtin_amdgcn_ballot_w64(skip != 0);
  if (lane == 0) ((int*)sRed)[8 + wid] = __builtin_popcountll(bal);
  __syncthreads();
  int kt0 = 0;
#pragma unroll
  for (int i = 0; i < 8; ++i) kt0 += ((const int*)sRed)[8 + i];
  f32x4 o[2][4];
#pragma unroll
  for (int mi = 0; mi < 2; ++mi)
#pragma unroll
    for (int d = 0; d < 4; ++d) o[mi][d] = (f32x4){0.f, 0.f, 0.f, 0.f};
  float mrun[2] = {-1e30f, -1e30f}, lsum[2] = {0.f, 0.f};
  const int skey = tid >> 3, sdg = tid & 7;
  const int kst = ((skey >> 4) * 2 + (sdg >> 2)) * 1024 + ((((skey & 15) * 64) + (sdg & 3) * 16) ^ (((skey >> 3) & 1) << 5));
  uint4 kreg, vreg; float freg = 0.f;
  {
    const size_t r = (size_t)(kt0 * 64 + skey) * NP;
    kreg = *(const uint4*)(projb + r + C_FK + fh * 64 + sdg * 8); vreg = *(const uint4*)(projb + r + C_FV + fh * 64 + sdg * 8);
    if (tid < 64) freg = (Fref - F[kt0 * 64 + tid]) * LOG2E;
  }
  {
    bf16_t* sK = (bf16_t*)(shm + (kt0 & 1) * STG); bf16_t* sV = sK + 64 * 72; float* sFk = (float*)(sV + 64 * 72);
    *(uint4*)((unsigned char*)sK + kst) = kreg; *(uint4*)(sV + skey * 72 + sdg * 8) = vreg;
    if (tid < 64) sFk[tid] = freg;
  }
  __syncthreads();
  for (int kt = kt0; kt < nkt; ++kt) {
    const int st = kt & 1;
    if (kt + 1 < nkt) {
      const size_t r = (size_t)((kt + 1) * 64 + skey) * NP;
      kreg = *(const uint4*)(projb + r + C_FK + fh * 64 + sdg * 8); vreg = *(const uint4*)(projb + r + C_FV + fh * 64 + sdg * 8);
      if (tid < 64) freg = (Fref - F[(kt + 1) * 64 + tid]) * LOG2E;
    }
    const bf16_t* sK = (const bf16_t*)(shm + st * STG); const bf16_t* sV = sK + 64 * 72; const float* sFk = (const float*)(sV + 64 * 72);
    if (kt * 64 <= q0 + wid * 32 + 31) {
      if (kt >= 4 * qb) fox_tile<true>(sK, sV, sFk, qf, o, mrun, lsum, kt * 64, qg0, fr, fq, lane);
      else fox_tile<false>(sK, sV, sFk, qf, o, mrun, lsum, kt * 64, qg0, fr, fq, lane);
    }
    if (kt + 1 < nkt) {
      bf16_t* nK = (bf16_t*)(shm + (st ^ 1) * STG); bf16_t* nV = nK + 64 * 72; float* nF = (float*)(nV + 64 * 72);
      *(uint4*)((unsigned char*)nK + kst) = kreg; *(uint4*)(nV + skey * 72 + sdg * 8) = vreg;
      if (tid < 64) nF[tid] = freg;
    }
    __syncthreads();
  }
#pragma unroll
  for (int mi = 0; mi < 2; ++mi) {
    float l = lsum[mi]; l += shx(l, 16, lane); l += shx(l, 32, lane);
    const float inv = 1.0f / l;
    bf16_t* gp = projb + (size_t)(qg0 + 16 * mi) * NP + C_FG + fh * 64 + 4 * fq;
#pragma unroll
    for (int d = 0; d < 4; ++d) {
      const uint2 gv = *(const uint2*)(gp + 16 * d);
      uint2 w;
      w.x = pk2(o[mi][d][0] * inv * silu_f(bflo(gv.x)), o[mi][d][1] * inv * silu_f(bfhi(gv.x)));
      w.y = pk2(o[mi][d][2] * inv * silu_f(bflo(gv.y)), o[mi][d][3] * inv * silu_f(bfhi(gv.y)));
      if (!dry || inv == 1.2345e-30f) *(uint2*)(gp + 16 * d) = w;
    }
  }
}

#define XB_TMO      128
#define XB_XCNT(j)  (256  + 64 * (j))
#define XB_XSUB(j)  (1280 + 64 * (j))
#define XB_XGEN(j)  (2304 + 64 * (j))
#define XB_TOP      3328
#define XB_TOPGEN   3392
#define XCD_BAR_WORDS 3456
#define XB_SPIN_CAP (1u << 20)
DI unsigned xb_ld(unsigned* p) { return __hip_atomic_load(p, __ATOMIC_RELAXED, __HIP_MEMORY_SCOPE_AGENT); }
DI unsigned xb_add(unsigned* p, unsigned v) { return __hip_atomic_fetch_add(p, v, __ATOMIC_RELAXED, __HIP_MEMORY_SCOPE_AGENT); }
DI unsigned xb_xcc_id() { return (unsigned)__builtin_amdgcn_s_getreg((3 << 11) | 20) & 0xFu; }
#define XB_SPIN(cond, bar) do { unsigned _sp = 0; while (cond) { __builtin_amdgcn_s_sleep(1); \
    if ((++_sp & 255u) == 0u) { if (xb_ld(&(bar)[XB_TMO])) break; if (_sp > XB_SPIN_CAP) { atomicAdd(&(bar)[XB_TMO], 1u); break; } } } } while (0)
struct XcdBarrier { unsigned* bar; unsigned x; volatile LDSP unsigned* st; };
DI XcdBarrier xcd_barrier_post(unsigned* bar, volatile LDSP unsigned* st) {
  XcdBarrier b; b.bar = bar; b.x = xb_xcc_id(); b.st = st;
  if (threadIdx.x == 0) (void)xb_add(&bar[XB_XCNT(b.x)], 1u);
  return b;
}
DI void xcd_barrier_complete(unsigned* bar, unsigned x, unsigned& nloc, unsigned& nx) {
  const unsigned G = gridDim.x;
  unsigned sum, cnt, mine, sp = 0u;
  for (;;) {
    sum = 0u; cnt = 0u; mine = 0u;
#pragma unroll
    for (unsigned j = 0; j < 16; ++j) { const unsigned c = xb_ld(&bar[XB_XCNT(j)]); sum += c; cnt += (c > 0u) ? 1u : 0u; mine = (j == x) ? c : mine; }
    if (sum == G) break;
    __builtin_amdgcn_s_sleep(1);
    if ((++sp & 255u) == 0u) { if (xb_ld(&bar[XB_TMO])) break; if (sp > XB_SPIN_CAP) { atomicAdd(&bar[XB_TMO], 1u); break; } }
  }
  nloc = mine > 0u ? mine : 1u; nx = cnt > 0u ? cnt : 1u;
}
DI void xcd_barrier(const XcdBarrier& b) {
  asm volatile("s_waitcnt vmcnt(0)" ::: "memory");
  __syncthreads();
  if (threadIdx.x == 0) {
    unsigned* bar = b.bar;
    __builtin_amdgcn_s_waitcnt(0);
    unsigned nloc = b.st[0], nx = b.st[1];
    if (nloc == 0u) { xcd_barrier_complete(bar, b.x, nloc, nx); b.st[0] = nloc; b.st[1] = nx; }
    const unsigned old = xb_add(&bar[XB_XSUB(b.x)], 1u);
    const unsigned gen = old / nloc;
    if (old + 1u == (gen + 1u) * nloc) {
      __builtin_amdgcn_fence(__ATOMIC_RELEASE, "agent");
      asm volatile("s_waitcnt vmcnt(0)" ::: "memory");
      const unsigned og = xb_add(&bar[XB_TOP], 1u);
      const unsigned tg = og / nx;
      if (og + 1u == (tg + 1u) * nx) xb_add(&bar[XB_TOPGEN], 1u);
      else XB_SPIN(xb_ld(&bar[XB_TOPGEN]) == tg, bar);
      __builtin_amdgcn_fence(__ATOMIC_ACQUIRE, "agent");
      xb_add(&bar[XB_XGEN(b.x)], 1u);
      asm volatile("s_waitcnt vmcnt(0)" ::: "memory");
    } else {
      XB_SPIN(xb_ld(&bar[XB_XGEN(b.x)]) == gen, bar);
      __builtin_amdgcn_fence(__ATOMIC_ACQUIRE, "agent");
      asm volatile("s_waitcnt vmcnt(0)" ::: "memory");
    }
  }
  __syncthreads();
}

DI int otid_(int wbase) { int t = wbase + (int)__builtin_amdgcn_mbcnt_hi(~0u, __builtin_amdgcn_mbcnt_lo(~0u, 0u)); asm volatile("" : "+v"(t)); return t; }
#define otid() otid_(wbase)
__global__ void __launch_bounds__(NTHR) mega(Params p) {
  extern __shared__ __attribute__((aligned(16))) unsigned char shm[];
  __shared__ uint4 s_words[2];
#define s_unit (*(int*)&s_words[1])
  cg::grid_group grid = cg::this_grid();
  const int wbase = __builtin_amdgcn_readfirstlane((int)(threadIdx.x & ~63u));
  const int tid = threadIdx.x;
  if (tid == 0) { s_words[0] = make_uint4(0u, 0u, 0u, 0u); s_words[1] = make_uint4(0u, 0u, 0u, 0u); }
  __syncthreads();
  int* ctr = (int*)(p.ws + WS_CTR);
  int phase_id = 0;
#ifndef X_P0
  phase0(p, shm, otid());
#endif
  grid.sync();
  (void)xcd_barrier_post((unsigned*)(ows(p) + WS_BAR), (volatile LDSP unsigned*)&s_words[0]);
#define GSYNC() do { XcdBarrier xb_; xb_.bar = (unsigned*)(ows(p) + WS_BAR); xb_.x = xb_xcc_id(); xb_.st = (volatile LDSP unsigned*)&s_words[0]; xcd_barrier(xb_); } while (0)
#if defined(PROBE_SYNC)
  for (int i = 0; i < 45; ++i) GSYNC();
#endif
  for (int layer = 0; layer < NLAYER; ++layer) {
    if (layer == 0) { norm_phase(p, 0, otid()); GSYNC(); }
    for (int hf = 0; hf < 2; ++hf) {
#ifndef X_G0
      gemm_phase<0>(p, layer, hf, shm, otid());
#endif
#if defined(PROBE_G0)
      gemm_phase<0>(p, layer, hf, shm, otid());
#endif
      GSYNC();
#if defined(PROBE_P2)
      for (int u = 16 + blockIdx.x; u < 16 + 256 + 512; u += gridDim.x) {
        if (u < 272) { const int k = u - 16; ssd_local_unit(p, layer, hf, k >> 7, (k >> 1) & 63, k & 1, shm, otid()); }
        else { const int k = u - 272; ret_local_unit(p, hf, k >> 8, (k >> 2) & 63, k & 3, shm, otid()); }
      }
#endif
      {
        int* my = ctr + 8 + phase_id;
        for (;;) {
          __syncthreads();
          if (otid() == 0) s_unit = atomicAdd(my, 1);
          __syncthreads();
          const int u0 = s_unit;
          const int n_fill = (hf == 0 && layer > 0) ? 256 : 0;
          int u = u0;
          if (u >= 784 + n_fill) break;
          if (u >= 16 && u < 16 + n_fill) { norm_unit(p, layer, 1, u - 16, otid()); continue; }
          if (u >= 16) u -= n_fill;
          if (u < 16) fox_cumsum_unit(p, hf, u >> 3, u & 7, shm, otid());
          else if (u < 272) { const int k = u - 16; ssd_local_unit(p, layer, hf, k >> 7, (k >> 1) & 63, k & 1, shm, otid()); }
          else { const int k = u - 272; ret_local_unit(p, hf, k >> 8, (k >> 2) & 63, k & 3, shm, otid()); }
        }
      }
      GSYNC();
      {
        int* my = ctr + phase_id; int* dep = ctr + 64 + phase_id; ++phase_id;
        bool dep_ok = false;
        for (;;) {
          __syncthreads();
          if (otid() == 0) s_unit = atomicAdd(my, 1);
          __syncthreads();
          const int u0 = s_unit;
          const int n_fill = (hf == 1) ? 256 : 0;
          int u = u0;
          if (u >= 1344 + n_fill) break;
          if (u >= 448 && u < 448 + n_fill) { norm_unit(p, layer + 1, 0, u - 448, otid()); continue; }
          if (u >= 448) u -= n_fill;
          const bool needs = (u >= 448 && u < 576) || (u >= 832);
          if (needs && !dep_ok) {
            if (otid() == 0) {
              unsigned sp = 0;
              while (__hip_atomic_load(dep, __ATOMIC_RELAXED, __HIP_MEMORY_SCOPE_AGENT) < 192) { __builtin_amdgcn_s_sleep(2); if (++sp > (1u << 22)) break; }
              __builtin_amdgcn_fence(__ATOMIC_ACQUIRE, "agent");
              asm volatile("s_waitcnt vmcnt(0)" ::: "memory");
            }
            __syncthreads();
            dep_ok = true;
          }
          if (u < 256) { fox_unit(p, hf, (u >> 3) & 1, u & 7, 31 - (u >> 4), shm, otid()); }
          else if (u < 448) {
            scan_unit(p, hf, u - 256, otid());
            asm volatile("s_waitcnt vmcnt(0)" ::: "memory");
            __syncthreads();
            if (otid() == 0) { __builtin_amdgcn_fence(__ATOMIC_RELEASE, "agent"); asm volatile("s_waitcnt vmcnt(0)" ::: "memory"); __hip_atomic_fetch_add(dep, 1, __ATOMIC_RELAXED, __HIP_MEMORY_SCOPE_AGENT); }
          }
          else if (u < 576) { const int k = u - 448; ssd_out_unit(p, layer, hf, k >> 6, k & 63, shm, otid()); }
          else if (u < 832) { const int k = u - 576 + 256; fox_unit(p, hf, (k >> 3) & 1, k & 7, 31 - (k >> 4), shm, otid()); }
          else { const int k = u - 832; ret_out_unit(p, hf, k >> 8, (k >> 2) & 63, k & 3, shm, otid()); }
        }
      }
      GSYNC();
#ifndef X_G1
      gemm_phase<1>(p, layer, hf, shm, otid());
#endif
      GSYNC();
    }
  }
  norm_rows(p, NLAYER, HROWS, HROWS, blockIdx.x * 8, gridDim.x * 8, otid());
}

extern "C" void kernel_launch(void* const* d_in, const int* in_sizes, int n_in, void* d_out, int out_size, void* d_ws, size_t ws_size, hipStream_t stream) {
  static int grid = 0;
  if (grid == 0) {
    int dev = 0, cus = 0, per_cu = 0;
    hipGetDevice(&dev);
    hipDeviceGetAttribute(&cus, hipDeviceAttributeMultiprocessorCount, dev);
    hipFuncSetAttribute((const void*)mega, hipFuncAttributeMaxDynamicSharedMemorySize, LDS_BYTES);
    if (hipOccupancyMaxActiveBlocksPerMultiprocessor(&per_cu, (const void*)mega, NTHR, LDS_BYTES) != hipSuccess || per_cu < 1) per_cu = 1;
    (void)hipGetLastError();
    grid = cus * per_cu;
    if (ws_size < WS_END || n_in != 16) { fprintf(stderr, "kernel_launch: workspace %zu < %zu or n_in %d != 16\n", ws_size, (size_t)WS_END, n_in); grid = -1; }
  }
  if (grid < 0) return;
  Params p{};
  p.x = (const float*)d_in[0]; p.c = (const float*)d_in[1]; p.pos = (const int*)d_in[2]; p.norm_g = (const float*)d_in[3];
  p.w_ada = (const float*)d_in[4]; p.b_ada = (const float*)d_in[5]; p.w_in = (const float*)d_in[6]; p.conv_w = (const float*)d_in[7];
  p.conv_b = (const float*)d_in[8]; p.dt_bias = (const float*)d_in[9]; p.a_log = (const float*)d_in[10]; p.d_skip = (const float*)d_in[11];
  p.ssd_norm_g = (const float*)d_in[12]; p.b_forget = (const float*)d_in[13]; p.w_out = (const float*)d_in[14]; p.final_g = (const float*)d_in[15];
  p.out = (float*)d_out; p.ws = (unsigned char*)d_ws;
  void* args[] = {&p};
  hipError_t e = hipLaunchCooperativeKernel((const void*)mega, dim3(grid), dim3(NTHR), args, LDS_BYTES, stream);
  if (e != hipSuccess) fprintf(stderr, "cooperative launch failed: %s (grid %d)\n", hipGetErrorString(e), grid);
}
```

```cpp
#include <hip/hip_runtime.h>
#include <hip/hip_cooperative_groups.h>
#include <cstdio>
#include <cmath>
namespace cg = cooperative_groups;

#define DI __device__ __forceinline__
typedef unsigned short bf16_t;
typedef short bf16x8 __attribute__((ext_vector_type(8)));
typedef float f32x4 __attribute__((ext_vector_type(4)));

constexpr int SEQ = 8192, DM = 1024, NLAYER = 4, ROWS = 32768, HROWS = 16384;
constexpr int NP = 6656;
constexpr int NWIN = 6912;
constexpr int NIN = 6680;
constexpr int C_RQ = 0, C_RK = 512, C_RV = 1024, C_XS = 1536, C_FQ = 3072, C_FK = 3584, C_FV = 4096, C_RG = 4608, C_Z = 5120, C_FG = 6144;
constexpr int NTHR = 512;
constexpr int LDS_BYTES = 147456;
constexpr float LOG2E = 1.4426950408889634f;
constexpr float EPS = 1e-6f;

constexpr size_t WS_PROJ = 0;
constexpr size_t WS_H = WS_PROJ + (size_t)HROWS * NP * 2;
constexpr size_t WS_SSTP = WS_H;
constexpr size_t WS_WIN = WS_H + (size_t)ROWS * DM * 2;
constexpr size_t WS_WOUT = WS_WIN + (size_t)NLAYER * NWIN * 1024 * 2;
constexpr size_t WS_RST = WS_WOUT + (size_t)NLAYER * 1024 * 2048 * 2;
constexpr size_t WS_SST = WS_RST + (size_t)2 * 64 * 4 * 16384 * 4;
constexpr size_t WS_CS = WS_SST + (size_t)2 * 64 * 16 * 8192 * 4;
constexpr size_t WS_TAIL = WS_CS + (size_t)ROWS * 64 * 8;
constexpr size_t WS_MOD = WS_TAIL + (size_t)ROWS * 24 * 4;
constexpr size_t WS_ASUM = WS_MOD + (size_t)NLAYER * 4 * 3072 * 4;
constexpr size_t WS_CTR = WS_ASUM + (size_t)2 * 64 * 16 * 4;
constexpr size_t WS_XC = WS_CTR + 1024;
constexpr size_t WS_BAR = WS_XC + (size_t)HROWS * 1536 * 2;
constexpr size_t WS_KMAX = WS_BAR + 16384;
constexpr size_t WS_FC = WS_KMAX + 256;
constexpr size_t WS_END = WS_FC + (size_t)2 * 8 * SEQ * 4;

struct Params {
  const float* x; const float* c; const int* pos; const float* norm_g; const float* w_ada; const float* b_ada;
  const float* w_in; const float* conv_w; const float* conv_b; const float* dt_bias; const float* a_log;
  const float* d_skip; const float* ssd_norm_g; const float* b_forget; const float* w_out; const float* final_g;
  float* out; unsigned char* ws;
};

DI unsigned pk2(float lo, float hi) { unsigned r; asm volatile("v_cvt_pk_bf16_f32 %0, %1, %2" : "=v"(r) : "v"(lo), "v"(hi)); return r; }
DI float bflo(unsigned u) { return __uint_as_float(u << 16); }
DI float bfhi(unsigned u) { return __uint_as_float(u & 0xffff0000u); }
DI float bf2f(bf16_t v) { return __uint_as_float(((unsigned)v) << 16); }
DI bf16_t f2bf(float f) { unsigned u = __float_as_uint(f); u += 0x7fffu + ((u >> 16) & 1u); return (bf16_t)(u >> 16); }
DI void unpack8(uint4 v, float* f) { f[0] = bflo(v.x); f[1] = bfhi(v.x); f[2] = bflo(v.y); f[3] = bfhi(v.y); f[4] = bflo(v.z); f[5] = bfhi(v.z); f[6] = bflo(v.w); f[7] = bfhi(v.w); }
DI uint4 pack8(const float* f) { uint4 r; r.x = pk2(f[0], f[1]); r.y = pk2(f[2], f[3]); r.z = pk2(f[4], f[5]); r.w = pk2(f[6], f[7]); return r; }
DI float silu_f(float x) { return x * __builtin_amdgcn_rcpf(1.0f + __expf(-x)); }
DI float softplus_f(float x) { return fmaxf(x, 0.f) + log1pf(__expf(-fabsf(x))); }
DI float ex2(float x) { return __builtin_amdgcn_exp2f(x); }
DI f32x4 mmaT(bf16x8 a_m, bf16x8 b_n, f32x4 c) { return __builtin_amdgcn_mfma_f32_16x16x32_bf16(b_n, a_m, c, 0, 0, 0); }
DI bf16x8 ldf(const bf16_t* s, int ld, int r0, int k0, int fr, int fq) { return *(const bf16x8*)(s + (r0 + fr) * ld + k0 + fq * 8); }
typedef short v4i16_t __attribute__((ext_vector_type(4)));
#define LDSP __attribute__((address_space(3)))
DI v4i16_t tr_rd(const bf16_t* a) { return __builtin_amdgcn_ds_read_tr16_b64_v4i16((LDSP v4i16_t*)a); }
DI bf16x8 frag_tr(const bf16_t* T, int ld, int k0, int n0, int fr, int fq) {
  const bf16_t* a = T + (k0 + 8 * fq + (fr >> 2)) * ld + n0 + 4 * (fr & 3);
  const v4i16_t lo = tr_rd(a), hi = tr_rd(a + 4 * ld);
  return __builtin_shufflevector(lo, hi, 0, 1, 2, 3, 4, 5, 6, 7);
}
DI float shx(float v, int m, int lane) { return __int_as_float(__builtin_amdgcn_ds_bpermute((lane ^ m) << 2, __float_as_int(v))); }
DI float shup(float v, int off, int lane) { return __int_as_float(__builtin_amdgcn_ds_bpermute((lane - off) << 2, __float_as_int(v))); }
DI bf16x8 mk8(unsigned a, unsigned b, unsigned c, unsigned d) { uint4 v; v.x = a; v.y = b; v.z = c; v.w = d; return __builtin_bit_cast(bf16x8, v); }

DI unsigned char* ows(const Params& p) { return p.ws; }
DI size_t wimg_off(int n, int k, int K) {
  const int r = n & 127, c = k & 31, ob = (r & 15) * 64 + c * 2;
  return ((size_t)(n >> 7) * (K >> 5) + (k >> 5)) * 4096 + (((r >> 4) * 1024 + (ob ^ (((ob >> 9) & 1) << 5))) >> 1);
}
DI void transpose_tile(const float* src, int src_ld, int k0, int sc0, bf16_t* dst, int dst_ld, int n0, float* sT  , int tid) {
  float4 v[8];
#pragma unroll
  for (int i = 0; i < 8; ++i) v[i] = *(const float4*)(src + (size_t)(k0 + (tid >> 6) + 8 * i) * src_ld + sc0 + (tid & 63) * 4);
#pragma unroll
  for (int i = 0; i < 8; ++i) { float* q = sT + ((tid >> 6) + 8 * i) * 257 + (tid & 63) * 4; q[0] = v[i].x; q[1] = v[i].y; q[2] = v[i].z; q[3] = v[i].w; }
  __syncthreads();
  {
    const int n = tid >> 1, kh = (tid & 1) * 32;
#pragma unroll
    for (int q = 0; q < 4; ++q) {
      const float* c = sT + (kh + 8 * q) * 257 + n;
      uint4 w;
      w.x = pk2(c[0], c[257]); w.y = pk2(c[2 * 257], c[3 * 257]); w.z = pk2(c[4 * 257], c[5 * 257]); w.w = pk2(c[6 * 257], c[7 * 257]);
      *(uint4*)(dst + wimg_off(n0 + n, k0 + kh + 8 * q, dst_ld)) = w;
    }
  }
  __syncthreads();
}

DI int win_src_col(int d) {
  if (d < 1536) return d;
  if (d < 3072) return d + 512;
  if (d < 4608) return d + 1552;
  if (d < 5120) return d - 3072;
  if (d < 6144) return d - 1520;
  return d + 16;
}

DI void phase0(const Params& p, unsigned char* shm, int tid) {
  unsigned char* wsb = ows(p);
  float* sT = (float*)shm;
  float* ssc = (float*)(shm + 69632);
  float* red = (float*)(shm + 69632 + 16384);
  bf16_t* wtin = (bf16_t*)(wsb + WS_WIN);
  bf16_t* wtout = (bf16_t*)(wsb + WS_WOUT);
  float* mod = (float*)(wsb + WS_MOD);
  for (int i = tid; i < 4096; i += NTHR) ssc[i] = silu_f(p.c[i]);
  __syncthreads();
  const int n_mod = 192, n_win = NLAYER * 16 * 26, n_wout = NLAYER * 32 * 4;
  for (int it = blockIdx.x; it < n_mod + n_win + n_wout; it += gridDim.x) {
    if (it < n_mod) {
      const int l = it / 48, cgp = it % 48, kc = tid >> 6, col = tid & 63;
      float a0 = 0.f, a1 = 0.f, a2 = 0.f, a3 = 0.f;
      const float* wp = p.w_ada + ((size_t)l * 1024 + kc * 128) * 3072 + cgp * 64 + col;
#pragma unroll 8
      for (int k = 0; k < 128; ++k) {
        const float w = wp[(size_t)k * 3072]; const int kk = kc * 128 + k;
        a0 += ssc[kk] * w; a1 += ssc[1024 + kk] * w; a2 += ssc[2048 + kk] * w; a3 += ssc[3072 + kk] * w;
      }
      red[(kc * 4 + 0) * 64 + col] = a0; red[(kc * 4 + 1) * 64 + col] = a1; red[(kc * 4 + 2) * 64 + col] = a2; red[(kc * 4 + 3) * 64 + col] = a3;
      __syncthreads();
      if (tid < 256) {
        const int b = tid >> 6, cc = tid & 63; float s = 0.f;
#pragma unroll
        for (int q = 0; q < 8; ++q) s += red[(q * 4 + b) * 64 + cc];
        mod[(size_t)(l * 4 + b) * 3072 + cgp * 64 + cc] = s + p.b_ada[l * 3072 + cgp * 64 + cc];
      }
      __syncthreads();
    } else if (it < n_mod + n_win) {
      const int j = it - n_mod, l = j / (16 * 26), r = j % (16 * 26), kt = r / 26, nt = r % 26;
      transpose_tile(p.w_in + (size_t)l * 1024 * NIN, NIN, kt * 64, win_src_col(nt * 256), wtin + (size_t)l * NWIN * 1024, 1024, nt * 256, sT, tid);
    } else {
      const int j = it - n_mod - n_win, l = j / 128, r = j % 128, kt = r / 4, nt = r % 4;
      transpose_tile(p.w_out + (size_t)l * 2048 * 1024, 1024, kt * 64, nt * 256, wtout + (size_t)l * 1024 * 2048, 2048, nt * 256, sT, tid);
    }
  }
  const int gtid = blockIdx.x * NTHR + tid, gn = gridDim.x * NTHR;
  for (int i = gtid; i < NLAYER * 256 * 1024; i += gn) {
    const int l = i / (256 * 1024), r = (i / 1024) % 256, k = i % 1024;
    float v = 0.f;
    if (r < 16) v = p.w_in[((size_t)l * 1024 + k) * NIN + 3584 + r];
    else if (r < 24) v = p.w_in[((size_t)l * 1024 + k) * NIN + 6672 + (r - 16)];
    wtin[(size_t)l * NWIN * 1024 + wimg_off(6656 + r, k, 1024)] = f2bf(v);
  }
  float2* cs = (float2*)(wsb + WS_CS);
  for (int i = gtid; i < ROWS * 64; i += gn) {
    const int row = i >> 6, fi = i & 63;
    const float ang = (float)p.pos[row] * (float)exp2(-(double)fi * (13.287712379549449 / 64.0));
    const double a = (double)ang;
    const double kq = rint(a * 0.6366197723675814);
    const float r = (float)fma(-kq, 1.5707963267948966, a);
    const float r2 = r * r;
    const float sn = r + r * r2 * (-1.6666667e-1f + r2 * (8.3333333e-3f + r2 * (-1.9841270e-4f + r2 * 2.7557319e-6f)));
    const float cn = 1.0f + r2 * (-0.5f + r2 * (4.1666667e-2f + r2 * (-1.3888889e-3f + r2 * (2.4801587e-5f + r2 * -2.7557319e-7f))));
    const int q = ((int)kq) & 3;
    float co, si;
    if (q == 0) { co = cn; si = sn; } else if (q == 1) { co = -sn; si = cn; } else if (q == 2) { co = -cn; si = -sn; } else { co = sn; si = -cn; }
    cs[i] = make_float2(co, si);
  }
  int* ctr = (int*)(wsb + WS_CTR);
  unsigned* barw = (unsigned*)(wsb + WS_BAR);
}

DI void norm_rows(const Params& p, int layer, int row0, int nrows, int wstart, int wstride, int tid) {
  unsigned char* wsb = ows(p);
  const float* xin = (layer == 0) ? p.x : p.out;
  const int wid = tid >> 6, lane = tid & 63;
  bf16_t* h = (bf16_t*)(wsb + WS_H);
  const float* modb = (const float*)(wsb + WS_MOD);
  for (int rowa = row0 + wstart + wid; rowa < row0 + nrows; rowa += 2 * wstride) {
    const int rowb = (rowa + wstride < row0 + nrows) ? rowa + wstride : rowa;
    float4 va[4], vb[4]; float sa = 0.f, sb = 0.f;
#pragma unroll
    for (int i = 0; i < 4; ++i) { va[i] = *(const float4*)(xin + (size_t)rowa * DM + i * 256 + lane * 4); vb[i] = *(const float4*)(xin + (size_t)rowb * DM + i * 256 + lane * 4); }
#pragma unroll
    for (int i = 0; i < 4; ++i) { sa += va[i].x * va[i].x + va[i].y * va[i].y + va[i].z * va[i].z + va[i].w * va[i].w; sb += vb[i].x * vb[i].x + vb[i].y * vb[i].y + vb[i].z * vb[i].z + vb[i].w * vb[i].w; }
#pragma unroll
    for (int o = 32; o >= 1; o >>= 1) { sa += shx(sa, o, lane); sb += shx(sb, o, lane); }
#pragma unroll
    for (int rr = 0; rr < 2; ++rr) {
      const int row = rr ? rowb : rowa; const float rinv = rsqrtf((rr ? sb : sa) * (1.0f / 1024.0f) + EPS);
      if (layer < NLAYER) {
        const int b = row >> 13; const float* md = modb + (size_t)(layer * 4 + b) * 3072; const float* g = p.norm_g + layer * 1024;
#pragma unroll
        for (int i = 0; i < 4; ++i) {
          const float4 x4 = rr ? vb[i] : va[i];
          const int e = i * 256 + lane * 4;
          const float4 g4 = *(const float4*)(g + e), sh = *(const float4*)(md + e), sc = *(const float4*)(md + 1024 + e);
          uint2 w;
          w.x = pk2(x4.x * rinv * g4.x * (1.f + sc.x) + sh.x, x4.y * rinv * g4.y * (1.f + sc.y) + sh.y);
          w.y = pk2(x4.z * rinv * g4.z * (1.f + sc.z) + sh.z, x4.w * rinv * g4.w * (1.f + sc.w) + sh.w);
          *(uint2*)(h + wimg_off(row, e, DM)) = w;
        }
      } else {
#pragma unroll
        for (int i = 0; i < 4; ++i) {
          const float4 x4 = rr ? vb[i] : va[i];
          const int e = i * 256 + lane * 4; const float4 g4 = *(const float4*)(p.final_g + e);
          float4 o4; o4.x = x4.x * rinv * g4.x; o4.y = x4.y * rinv * g4.y; o4.z = x4.z * rinv * g4.z; o4.w = x4.w * rinv * g4.w;
          *(float4*)(p.out + (size_t)row * DM + e) = o4;
        }
      }
    }
  }
}
DI void norm_phase(const Params& p, int layer, int tid) { norm_rows(p, layer, 0, ROWS, blockIdx.x * 8, gridDim.x * 8, tid); }
DI void norm_unit(const Params& p, int layer, int half, int nu, int tid) { norm_rows(p, layer, half * HROWS + nu * 64, 64, 0, 8, tid); }
constexpr int BM = 256, BK = 64, HALF = 128, HT = HALF * BK;
DI int lds_byte(int r, int c) { int st = (r >> 4) * 2 + (c >> 5), rr = r & 15, cc = c & 31, ob = rr * 64 + cc * 2; return st * 1024 + (ob ^ (((ob >> 9) & 1) << 5)); }
DI void stage_rc(int b, int& R, int& C) { int st = b / 1024, sb = b % 1024, swz = sb ^ (((sb >> 9) & 1) << 5); R = (st >> 1) * 16 + swz / 64; C = (st & 1) * 32 + (swz % 64) / 2; }
struct Unit { int pm, pn; };
DI bool unit_next(int i, int G, int c, int nM, int nN, Unit& u) {
  const int nwg = nM * nN; const long Lx = (long)i * G + c; if (Lx >= nwg) return false;
  int wgid = (int)Lx; { const int q = nwg / 8, r = nwg % 8, xcd = wgid % 8, off = wgid / 8; wgid = (xcd < r ? xcd * (q + 1) : r * (q + 1) + (xcd - r) * q) + off; }
  const int nig = 8 * nN, gid = wgid / nig, fm = gid * 8, gsz = (nM - fm) < 8 ? (nM - fm) : 8;
  u.pm = fm + ((wgid % nig) % gsz); u.pn = (wgid % nig) / gsz; return true;
}

template <int MODE>
DI void gemm_phase(const Params& p, int layer, int hf, unsigned char* shmc, int tid) {
  unsigned char* wsb = ows(p);
  const bf16_t* A; const bf16_t* Bt; int lda, ldb, K, nM, nN;
  if (MODE == 0) { A = (const bf16_t*)(wsb + WS_H) + (size_t)hf * HROWS * DM; lda = DM; Bt = (const bf16_t*)(wsb + WS_WIN) + (size_t)layer * NWIN * 1024; ldb = 1024; K = 1024; nM = HROWS / BM; nN = NWIN / BM; }
  else { A = (const bf16_t*)(wsb + WS_PROJ) + C_RG; lda = NP; Bt = (const bf16_t*)(wsb + WS_WOUT) + (size_t)layer * 1024 * 2048; ldb = 2048; K = 2048; nM = HROWS / BM; nN = DM / BM; }
#define WAIT_V(n) asm volatile("s_waitcnt vmcnt(" #n ")" ::: "memory")
#define BAR __builtin_amdgcn_s_barrier()
  const int wid = tid >> 6, lane = tid & 63, wr = wid >> 2, wc = wid & 3, fr = lane & 15, fq = lane >> 4;
  constexpr int BK2 = 32, NST = 4;
  const int nt = K / BK2;
  int la0, lb0;
  { const int ob = fr * 64 + fq * 16, sw = ob ^ (((ob >> 9) & 1) << 5); la0 = (wr * 4) * 1024 + sw; lb0 = (wc * 2) * 1024 + sw; }
  Unit u, un;
  bool have = unit_next(0, gridDim.x, blockIdx.x, nM, nN, u), pre = false;
  for (int ui = 0; have; ++ui) {
    const bool have_n = unit_next(ui + 1, gridDim.x, blockIdx.x, nM, nN, un);
    const int brow = u.pm * BM, bcol = u.pn * BM;
    f32x4 acc[2][2][4][2];
#pragma unroll
    for (int a = 0; a < 2; ++a)
#pragma unroll
      for (int b = 0; b < 2; ++b)
#pragma unroll
        for (int m = 0; m < 4; ++m)
#pragma unroll
          for (int n = 0; n < 2; ++n) acc[a][b][m][n] = (f32x4){0.f, 0.f, 0.f, 0.f};
    const bf16_t* gA = (MODE == 0) ? A + (size_t)(brow >> 7) * nt * 4096 : A + (size_t)brow * lda; const bf16_t* gB = Bt + (size_t)(bcol >> 7) * nt * 4096;
#define STAGE_ALL(st, kt) do { int _t = tid; asm volatile("" : "+v"(_t)); unsigned char* _s = shmc + (st) * 32768 + _t * 16; \
      const int _sb = (_t & 63) * 16, _sw = _sb ^ (((_sb >> 9) & 1) << 5), _r = (_t >> 6) * 16 + (_sw >> 6), _c = (_sw & 63) >> 1; \
      const int _oa = _r * lda + _c + (kt) * BK2; \
      _Pragma("unroll") for (int _h = 0; _h < 2; ++_h) { \
        __builtin_amdgcn_global_load_lds((const unsigned*)((MODE == 0) ? gA + ((size_t)_h * nt + (kt)) * 4096 + _t * 8 : gA + (size_t)_h * HALF * lda + _oa), (unsigned*)(_s + _h * 8192), 16, 0, 0); \
        __builtin_amdgcn_global_load_lds((const unsigned*)(gB + ((size_t)_h * nt + (kt)) * 4096 + _t * 8), (unsigned*)(_s + 16384 + _h * 8192), 16, 0, 0); } } while (0)
    if (!pre) { STAGE_ALL(0, 0); STAGE_ALL(1, 1); }
    STAGE_ALL(2, 2);
    for (int kt = 0; kt < nt; ++kt) {
      const int rem = nt - 1 - kt;
      if (rem >= 2) WAIT_V(8); else if (rem == 1) WAIT_V(4); else WAIT_V(0);
      BAR;
      const unsigned char* sb = shmc + (kt & 3) * 32768;
#define LDA_(dst, ai) _Pragma("unroll") for (int m = 0; m < 4; ++m) dst[m] = *(const bf16x8*)(sb + (ai) * 8192 + la0 + m * 1024)
#define LDB_(dst) _Pragma("unroll") for (int bj = 0; bj < 2; ++bj) _Pragma("unroll") for (int n = 0; n < 2; ++n) dst[bj][n] = *(const bf16x8*)(sb + 16384 + bj * 8192 + lb0 + n * 1024)
#define MMA_(ai, bf_, af_) _Pragma("unroll") for (int bj = 0; bj < 2; ++bj) _Pragma("unroll") for (int m = 0; m < 4; ++m) _Pragma("unroll") for (int n = 0; n < 2; ++n) \
        acc[ai][bj][m][n] = __builtin_amdgcn_mfma_f32_16x16x32_bf16(bf_[bj][n], af_[m], acc[ai][bj][m][n], 0, 0, 0)
      {
        bf16x8 b0[2][2], a0[4], a1[4];
        LDB_(b0); LDA_(a0, 0);
        __builtin_amdgcn_sched_barrier(0);
        LDA_(a1, 1); MMA_(0, b0, a0);
        __builtin_amdgcn_sched_barrier(0);
        if (kt + 3 < nt) STAGE_ALL((kt + 3) & 3, kt + 3);
        __builtin_amdgcn_sched_barrier(0);
        MMA_(1, b0, a1);
      }
#undef LDA_
#undef LDB_
#undef MMA_
    }
    __syncthreads();
    pre = false;
    if (pre) {
      gA = A + (size_t)((un.pm * BM) >> 7) * nt * 4096; gB = Bt + (size_t)((un.pn * BM) >> 7) * nt * 4096;
      STAGE_ALL(0, 0); STAGE_ALL(1, 1);
    }
    const int row_b = brow + wr * 64 + fr, col_b = bcol + wc * 32 + fq * 4;
    if (MODE == 0) {
      if (u.pn < 26) {
        bf16_t* proj = (bf16_t*)(wsb + WS_PROJ);
        unsigned char* es = shmc + 65536;
#pragma unroll
        for (int ai = 0; ai < 2; ++ai) {
#pragma unroll
          for (int m = 0; m < 4; ++m) {
            unsigned char* rp = es + (wr * 64 + m * 16 + fr) * 528 + (wc * 32 + fq * 4) * 2;
#pragma unroll
            for (int bj = 0; bj < 2; ++bj)
#pragma unroll
              for (int n = 0; n < 2; ++n) { const f32x4 v = acc[ai][bj][m][n]; uint2 w; w.x = pk2(v[0], v[1]); w.y = pk2(v[2], v[3]); *(uint2*)(rp + (bj * HALF + n * 16) * 2) = w; }
          }
          __syncthreads();
          {
            const int r0 = tid >> 5, ch = tid & 31;
#pragma unroll
            for (int i = 0; i < 8; ++i) {
              const int row = r0 + 16 * i;
              { typedef unsigned u32x4_t __attribute__((ext_vector_type(4))); const u32x4_t v_ = *(const u32x4_t*)(es + row * 528 + ch * 16); __builtin_nontemporal_store(v_, (u32x4_t*)(proj + (size_t)(brow + ai * HALF + row) * NP + bcol + ch * 8)); }
            }
          }
          __syncthreads();
        }
      } else {
        float* tail = (float*)(wsb + WS_TAIL);
        float* sT = (float*)shmc;
        if (wc == 0) {
#pragma unroll
          for (int ai = 0; ai < 2; ++ai)
#pragma unroll
            for (int m = 0; m < 4; ++m)
#pragma unroll
              for (int n = 0; n < 2; ++n) *(f32x4*)(sT + (ai * HALF + wr * 64 + m * 16 + fr) * 36 + n * 16 + fq * 4) = acc[ai][0][m][n];
        }
        __syncthreads();
        float* tp = tail + (size_t)(hf * HROWS + brow) * 24;
#pragma unroll 1
        for (int idx = tid; idx < 256 * 24; idx += NTHR) {
          const int row = idx / 24, col = idx - row * 24;
          const float v = sT[row * 36 + col];
          float r;
          if (col < 16) r = softplus_f(v + p.dt_bias[layer * 16 + col]);
          else r = -softplus_f(-(v + p.b_forget[layer * 8 + col - 16]));
          tp[idx] = r;
        }
        __syncthreads();
      }
    } else {
      const float* xin = (layer == 0) ? p.x : p.out;
      const float* modb = (const float*)(wsb + WS_MOD);
#pragma unroll
      for (int ai = 0; ai < 2; ++ai) {
#pragma unroll
        for (int m = 0; m < 4; ++m) {
          unsigned char* rp = shmc + (wr * 64 + m * 16 + fr) * 1040 + (wc * 32 + fq * 4) * 4;
#pragma unroll
          for (int bj = 0; bj < 2; ++bj)
#pragma unroll
            for (int n = 0; n < 2; ++n) *(f32x4*)(rp + (bj * HALF + n * 16) * 4) = acc[ai][bj][m][n];
        }
        __syncthreads();
        {
          const int r0 = tid >> 6, ch = tid & 63;
          const int growb = hf * HROWS + brow + ai * HALF;
          const float* gate = modb + (size_t)(layer * 4 + (growb >> 13)) * 3072 + 2048 + bcol + ch * 4;
          const float4 g = *(const float4*)gate;
#pragma unroll 4
          for (int i = 0; i < 16; ++i) {
            const int row = r0 + 8 * i;
            const float4 v = *(const float4*)(shmc + row * 1040 + ch * 16);
            const size_t off = (size_t)(growb + row) * DM + bcol + ch * 4;
            const f32x4 xo = __builtin_nontemporal_load((const f32x4*)(xin + off));
            f32x4 o; o[0] = xo[0] + g.x * v.x; o[1] = xo[1] + g.y * v.y; o[2] = xo[2] + g.z * v.z; o[3] = xo[3] + g.w * v.w;
            __builtin_nontemporal_store(o, (f32x4*)(p.out + off));
          }
        }
        __syncthreads();
      }
    }
    u = un; have = have_n;
  }
#undef STAGE_ALL
#undef WAIT_V
#undef BAR
}

DI void conv8(const bf16_t* projb, int t, int ch0, const float* cw, const float* cb, float* o) {
  const float4 b0 = *(const float4*)(cb + ch0), b1 = *(const float4*)(cb + ch0 + 4);
  float a[8] = {b0.x, b0.y, b0.z, b0.w, b1.x, b1.y, b1.z, b1.w};
#pragma unroll
  for (int i = 0; i < 4; ++i) {
    const int tt = t - 3 + i;
    if (tt >= 0) {
      const uint4 raw = *(const uint4*)(projb + (size_t)tt * NP + C_XS + ch0);
      const float4 w0 = *(const float4*)(cw + i * 1536 + ch0), w1 = *(const float4*)(cw + i * 1536 + ch0 + 4);
      float u[8]; unpack8(raw, u);
      a[0] += w0.x * u[0]; a[1] += w0.y * u[1]; a[2] += w0.z * u[2]; a[3] += w0.w * u[3];
      a[4] += w1.x * u[4]; a[5] += w1.y * u[5]; a[6] += w1.z * u[6]; a[7] += w1.w * u[7];
    }
  }
#pragma unroll
  for (int e = 0; e < 8; ++e) o[e] = silu_f(a[e]);
}

constexpr int LD = 136;

DI void wave_cumsum128(float a0, float a1, int lane, float& c0, float& c1, float& last) {
  const float s1 = a0 + a1; float v = s1;
#pragma unroll
  for (int off = 1; off < 64; off <<= 1) { const float t = shup(v, off, lane); if (lane >= off) v += t; }
  const float ex = v - s1; c0 = ex + a0; c1 = ex + s1; last = __int_as_float(__builtin_amdgcn_readlane(__float_as_int(v), 63));
}

DI void ret_local_unit(const Params& p, int hf, int bl, int c, int hd, unsigned char* shm, int tid) {
  unsigned char* wsb = ows(p);
  bf16_t* sK = (bf16_t*)shm; bf16_t* sV = sK + 128 * LD;
  const bf16_t* projb = (const bf16_t*)(wsb + WS_PROJ) + (size_t)bl * SEQ * NP;
  const float2* cs = (const float2*)(wsb + WS_CS) + (size_t)((hf * 2 + bl) * SEQ + c * 128) * 64;
  const float lg = logf(1.0f - ex2(-5.0f - (float)hd));
#pragma unroll
  for (int it = 0; it < 2; ++it) {
    const int idx = tid + it * NTHR, j = idx >> 3, dg = idx & 7;
    const bf16_t* base = projb + (size_t)(c * 128 + j) * NP;
    float k1[8], k2[8]; unpack8(*(const uint4*)(base + C_RK + hd * 128 + dg * 8), k1); unpack8(*(const uint4*)(base + C_RK + hd * 128 + 64 + dg * 8), k2);
    const float w = __expf(lg * (float)(127 - j)) * 0.08838834764831845f;
    float o1[8], o2[8];
#pragma unroll
    for (int e = 0; e < 8; ++e) {
      const float2 t = cs[j * 64 + dg * 8 + e];
      o1[e] = (k1[e] * t.x - k2[e] * t.y) * w; o2[e] = (k1[e] * t.y + k2[e] * t.x) * w;
    }
    *(uint4*)(sK + j * LD + dg * 8) = pack8(o1); *(uint4*)(sK + j * LD + 64 + dg * 8) = pack8(o2);
    *(uint4*)(sV + j * LD + dg * 16) = *(const uint4*)(base + C_RV + hd * 128 + dg * 16);
    *(uint4*)(sV + j * LD + dg * 16 + 8) = *(const uint4*)(base + C_RV + hd * 128 + dg * 16 + 8);
  }
  __syncthreads();
  const int wid = tid >> 6, lane = tid & 63, fr = lane & 15, fq = lane >> 4;
  f32x4 acc[8];
#pragma unroll
  for (int n = 0; n < 8; ++n) acc[n] = (f32x4){0.f, 0.f, 0.f, 0.f};
#pragma unroll
  for (int ks = 0; ks < 4; ++ks) {
    const bf16x8 a = frag_tr(sV, LD, 32 * ks, 16 * wid, fr, fq);
#pragma unroll
    for (int n = 0; n < 8; ++n) acc[n] = mmaT(a, frag_tr(sK, LD, 32 * ks, 16 * n, fr, fq), acc[n]);
  }
  bf16_t* st = (bf16_t*)(wsb + WS_RST) + (size_t)((bl * 64 + c) * 4 + hd) * 16384;
#pragma unroll
  for (int n = 0; n < 8; ++n) { uint2 w; w.x = pk2(acc[n][0], acc[n][1]); w.y = pk2(acc[n][2], acc[n][3]); *(uint2*)(st + (16 * wid + fr) * 128 + 16 * n + 4 * fq) = w; }
  __syncthreads();
}

#define CONV_RUN8(projb, t0, ch0, cw, cb, EMIT) do { \
    float w_[4][8], b_[8], win_[3][8]; \
    { const float4 x0 = *(const float4*)((cb) + (ch0)), x1 = *(const float4*)((cb) + (ch0) + 4); b_[0] = x0.x; b_[1] = x0.y; b_[2] = x0.z; b_[3] = x0.w; b_[4] = x1.x; b_[5] = x1.y; b_[6] = x1.z; b_[7] = x1.w; } \
    _Pragma("unroll") for (int i_ = 0; i_ < 4; ++i_) { const float4 x0 = *(const float4*)((cw) + i_ * 1536 + (ch0)), x1 = *(const float4*)((cw) + i_ * 1536 + (ch0) + 4); \
      w_[i_][0] = x0.x; w_[i_][1] = x0.y; w_[i_][2] = x0.z; w_[i_][3] = x0.w; w_[i_][4] = x1.x; w_[i_][5] = x1.y; w_[i_][6] = x1.z; w_[i_][7] = x1.w; } \
    uint4 raw_[11]; \
    _Pragma("unroll") for (int i_ = 0; i_ < 11; ++i_) { const int tt_ = (t0) - 3 + i_; raw_[i_] = (tt_ >= 0) ? *(const uint4*)((projb) + (size_t)tt_ * NP + C_XS + (ch0)) : make_uint4(0u, 0u, 0u, 0u); } \
    _Pragma("unroll") for (int i_ = 0; i_ < 3; ++i_) unpack8(raw_[i_], win_[i_]); \
    _Pragma("unroll") for (int r_ = 0; r_ < 8; ++r_) { float cur_[8], o_[8]; unpack8(raw_[3 + r_], cur_); \
      _Pragma("unroll") for (int e_ = 0; e_ < 8; ++e_) { o_[e_] = silu_f(b_[e_] + w_[0][e_] * win_[0][e_] + w_[1][e_] * win_[1][e_] + w_[2][e_] * win_[2][e_] + w_[3][e_] * cur_[e_]); \
        win_[0][e_] = win_[1][e_]; win_[1][e_] = win_[2][e_]; win_[2][e_] = cur_[e_]; } \
      EMIT(r_, o_); } } while (0)

DI void ssd_local_unit(const Params& p, int layer, int hf, int bl, int c, int g, unsigned char* shm, int tid) {
  unsigned char* wsb = ows(p);
  constexpr int LX = 264;
  bf16_t* sB = (bf16_t*)shm; bf16_t* sX = sB + 128 * LD;
  float* sW = (float*)(sX + 128 * LX);
  const bf16_t* projb = (const bf16_t*)(wsb + WS_PROJ) + (size_t)bl * SEQ * NP;
  bf16_t* xcb = (bf16_t*)(wsb + WS_XC) + (size_t)(bl * SEQ) * 1536;
  const float* tail = (const float*)(wsb + WS_TAIL) + (size_t)((hf * 2 + bl) * SEQ + c * 128) * 24;
  const float* cw = p.conv_w + (size_t)layer * 4 * 1536; const float* cb = p.conv_b + layer * 1536;
  const int wid = tid >> 6, lane = tid & 63, fr = lane & 15, fq = lane >> 4;
  {
    const int h = g * 8 + wid; const float Ah = -__expf(p.a_log[layer * 16 + h]);
    const float d0 = tail[(2 * lane) * 24 + h], d1 = tail[(2 * lane + 1) * 24 + h];
    float c0, c1, last; wave_cumsum128(d0 * Ah, d1 * Ah, lane, c0, c1, last);
    sW[wid * 128 + 2 * lane] = d0 * __expf(last - c0); sW[wid * 128 + 2 * lane + 1] = d1 * __expf(last - c1);
    if (lane == 0) ((float*)(wsb + WS_ASUM))[(bl * 64 + c) * 16 + h] = last;
  }
  const int cgi = tid & 31, trg = tid >> 5, t0 = c * 128 + trg * 8;
  {
    const int ch0 = (cgi < 16) ? (1024 + g * 128 + cgi * 8) : (1280 + g * 128 + (cgi - 16) * 8);
#define EMIT_BC(r, o) do { const uint4 pk_ = pack8(o); *(uint4*)(xcb + (size_t)(t0 + (r)) * 1536 + ch0) = pk_; if (cgi < 16) *(uint4*)(sB + (trg * 8 + (r)) * LD + cgi * 8) = pk_; } while (0)
    CONV_RUN8(projb, t0, ch0, cw, cb, EMIT_BC);
#undef EMIT_BC
  }
  __syncthreads();
  for (int hb = 0; hb < 2; ++hb) {
    {
      const int hq = cgi >> 3, ch0 = (g * 8 + hb * 4) * 64 + cgi * 8;
#define EMIT_X(r, o) do { *(uint4*)(xcb + (size_t)(t0 + (r)) * 1536 + ch0) = pack8(o); const float w__ = sW[(hb * 4 + hq) * 128 + trg * 8 + (r)]; \
        float s__[8]; _Pragma("unroll") for (int e__ = 0; e__ < 8; ++e__) s__[e__] = (o)[e__] * w__; *(uint4*)(sX + (trg * 8 + (r)) * LX + cgi * 8) = pack8(s__); } while (0)
      CONV_RUN8(projb, t0, ch0, cw, cb, EMIT_X);
#undef EMIT_X
    }
    __syncthreads();
    const int hq = wid >> 1, nh = wid & 1;
    f32x4 acc[4][4];
#pragma unroll
    for (int m = 0; m < 4; ++m)
#pragma unroll
      for (int n = 0; n < 4; ++n) acc[m][n] = (f32x4){0.f, 0.f, 0.f, 0.f};
#pragma unroll
    for (int ks = 0; ks < 4; ++ks) {
      bf16x8 bfr[4];
#pragma unroll
      for (int n = 0; n < 4; ++n) bfr[n] = frag_tr(sB, LD, 32 * ks, nh * 64 + 16 * n, fr, fq);
#pragma unroll
      for (int m = 0; m < 4; ++m) {
        const bf16x8 a = frag_tr(sX, LX, 32 * ks, hq * 64 + 16 * m, fr, fq);
#pragma unroll
        for (int n = 0; n < 4; ++n) acc[m][n] = mmaT(a, bfr[n], acc[m][n]);
      }
    }
    float* st = (float*)(wsb + WS_SST) + (size_t)((bl * 64 + c) * 16 + g * 8 + hb * 4 + hq) * 8192;
#pragma unroll
    for (int m = 0; m < 4; ++m)
#pragma unroll
      for (int n = 0; n < 4; ++n) *(f32x4*)(st + (16 * m + fr) * 128 + nh * 64 + 16 * n + 4 * fq) = acc[m][n];
    __syncthreads();
  }
}

DI void fox_cumsum_unit(const Params& p, int hf, int bl, int fh, unsigned char* shm, int tid) {
  unsigned char* wsb = ows(p);
  float* sWv = (float*)shm;
  float* base = (float*)(wsb + WS_TAIL) + (size_t)((hf * 2 + bl) * SEQ) * 24 + 16 + fh;
  const int wid = tid >> 6, lane = tid & 63;
  float v[16];
#pragma unroll
  for (int e = 0; e < 16; ++e) v[e] = base[(size_t)(tid * 16 + e) * 24];
#pragma unroll
  for (int e = 1; e < 16; ++e) v[e] += v[e - 1];
  const float tot = v[15]; float inc = tot;
#pragma unroll
  for (int off = 1; off < 64; off <<= 1) { const float t = shup(inc, off, lane); if (lane >= off) inc += t; }
  if (lane == 63) sWv[wid] = inc;
  __syncthreads();
  float woff = 0.f;
  for (int i = 0; i < wid; ++i) woff += sWv[i];
  const float ex = woff + inc - tot;
  { float* fc = (float*)(wsb + WS_FC) + (size_t)(bl * 8 + fh) * SEQ + tid * 16;
#pragma unroll
    for (int e = 0; e < 16; e += 4) { float4 w4; w4.x = v[e] + ex; w4.y = v[e + 1] + ex; w4.z = v[e + 2] + ex; w4.w = v[e + 3] + ex; *(float4*)(fc + e) = w4; } }
  const bf16_t* kb = (const bf16_t*)(wsb + WS_PROJ) + (size_t)(bl * SEQ + tid * 16) * NP + C_FK + fh * 64;
  float kmx = 0.f;
#pragma unroll 4
  for (int e = 0; e < 16; ++e) {
    float ssum = 0.f;
#pragma unroll
    for (int q = 0; q < 8; ++q) { float f[8]; unpack8(*(const uint4*)(kb + (size_t)e * NP + q * 8), f);
#pragma unroll
      for (int z = 0; z < 8; ++z) ssum += f[z] * f[z]; }
    kmx = fmaxf(kmx, ssum);
  }
#pragma unroll
  for (int o = 32; o >= 1; o >>= 1) kmx = fmaxf(kmx, shx(kmx, o, lane));
  __syncthreads();
  if (lane == 0) sWv[16 + wid] = kmx;
  __syncthreads();
  if (tid == 0) { float m = 0.f; for (int i = 0; i < 8; ++i) m = fmaxf(m, sWv[16 + i]); ((float*)(wsb + WS_KMAX))[bl * 8 + fh] = m; }
  __syncthreads();
}

DI void scan_unit(const Params& p, int hf, int su, int tid) {
  unsigned char* wsb = ows(p);
  const int gtid = su * NTHR + tid, gn = 1 << 30;
  bf16_t* rst = (bf16_t*)(wsb + WS_RST); float* sst = (float*)(wsb + WS_SST); const float* asum = (const float*)(wsb + WS_ASUM);
  const int n_r = 2 * 4 * 4096, n_s = 2 * 16 * 2048;
  for (int i = gtid; i < n_r + n_s; i += gn) {
    if (i < n_r) {
      float S0 = 0.f, S1 = 0.f, S2 = 0.f, S3 = 0.f;
      const int bl = i / 16384, hd = (i / 4096) & 3, e = (i & 4095) * 4;
      const float dc = __expf(logf(1.0f - ex2(-5.0f - (float)hd)) * 128.0f);
      bf16_t* ptr = rst + (size_t)(bl * 64 * 4 + hd) * 16384 + e;
#pragma unroll 8
      for (int c = 0; c < 64; ++c) {
        uint2* q = (uint2*)(ptr + (size_t)c * 4 * 16384); const uint2 v = *q;
        uint2 w; w.x = pk2(S0, S1); w.y = pk2(S2, S3); *q = w;
        S0 = S0 * dc + bflo(v.x); S1 = S1 * dc + bfhi(v.x); S2 = S2 * dc + bflo(v.y); S3 = S3 * dc + bfhi(v.y);
      }
    } else {
      const int k = i - n_r, bl = k / 32768, h = (k / 2048) & 15, e = (k & 2047) * 4;
      float S0 = 0.f, S1 = 0.f, S2 = 0.f, S3 = 0.f;
      const float* ptr = sst + (size_t)(bl * 64 * 16 + h) * 8192 + e;
      bf16_t* pp = (bf16_t*)(wsb + WS_SSTP + (size_t)hf * HROWS * DM * 2) + (size_t)(bl * 64 * 16 + h) * 8192 + e;
#pragma unroll 8
      for (int c = 0; c < 64; ++c) {
        const float4 lo = *(const float4*)(ptr + (size_t)c * 16 * 8192);
        uint2 w; w.x = pk2(S0, S1); w.y = pk2(S2, S3); *(uint2*)(pp + (size_t)c * 16 * 8192) = w;
        const float dc = __expf(asum[(bl * 64 + c) * 16 + h]);
        S0 = S0 * dc + lo.x; S1 = S1 * dc + lo.y; S2 = S2 * dc + lo.z; S3 = S3 * dc + lo.w;
      }
    }
  }
}

DI void ret_out_unit(const Params& p, int hf, int bl, int c, int hd, unsigned char* shm, int tid, bool dry = false) {
  unsigned char* wsb = ows(p);
  bf16_t* sQ = (bf16_t*)shm; bf16_t* sK = sQ + 128 * LD; bf16_t* sVt = sK + 128 * LD; bf16_t* sS = sVt + 128 * LD;
  bf16_t* projb = (bf16_t*)(wsb + WS_PROJ) + (size_t)bl * SEQ * NP;
  const float2* cs = (const float2*)(wsb + WS_CS) + (size_t)((hf * 2 + bl) * SEQ + c * 128) * 64;
  const float lg = logf(1.0f - ex2(-5.0f - (float)hd));
#pragma unroll
  for (int it = 0; it < 2; ++it) {
    const int idx = tid + it * NTHR, j = idx >> 3, dg = idx & 7;
    const bf16_t* base = projb + (size_t)(c * 128 + j) * NP;
    float q1[8], q2[8], k1[8], k2[8];
    unpack8(*(const uint4*)(base + C_RQ + hd * 128 + dg * 8), q1); unpack8(*(const uint4*)(base + C_RQ + hd * 128 + 64 + dg * 8), q2);
    unpack8(*(const uint4*)(base + C_RK + hd * 128 + dg * 8), k1); unpack8(*(const uint4*)(base + C_RK + hd * 128 + 64 + dg * 8), k2);
    float oq1[8], oq2[8], ok1[8], ok2[8];
#pragma unroll
    for (int e = 0; e < 8; ++e) {
      const float2 t = cs[j * 64 + dg * 8 + e];
      oq1[e] = q1[e] * t.x - q2[e] * t.y; oq2[e] = q1[e] * t.y + q2[e] * t.x;
      ok1[e] = (k1[e] * t.x - k2[e] * t.y) * 0.08838834764831845f; ok2[e] = (k1[e] * t.y + k2[e] * t.x) * 0.08838834764831845f;
    }
    *(uint4*)(sQ + j * LD + dg * 8) = pack8(oq1); *(uint4*)(sQ + j * LD + 64 + dg * 8) = pack8(oq2);
    *(uint4*)(sK + j * LD + dg * 8) = pack8(ok1); *(uint4*)(sK + j * LD + 64 + dg * 8) = pack8(ok2);
    *(uint4*)(sVt + j * LD + dg * 16) = *(const uint4*)(base + C_RV + hd * 128 + dg * 16);
    *(uint4*)(sVt + j * LD + dg * 16 + 8) = *(const uint4*)(base + C_RV + hd * 128 + dg * 16 + 8);
  }
  __syncthreads();
  const int wid = tid >> 6, lane = tid & 63, fr = lane & 15, fq = lane >> 4;
  const int i_row = 16 * wid + fr;
  uint4 stv0, stv1, stv2, stv3; uint2 gv8[8];
  {
    const bf16_t* st = (const bf16_t*)(wsb + WS_RST) + (size_t)((bl * 64 + c) * 4 + hd) * 16384;
    { const int e0 = tid >> 3, dg = tid & 7; stv0 = *(const uint4*)(st + e0 * 128 + dg * 16); stv1 = *(const uint4*)(st + e0 * 128 + dg * 16 + 8); stv2 = *(const uint4*)(st + (e0 + 64) * 128 + dg * 16); stv3 = *(const uint4*)(st + (e0 + 64) * 128 + dg * 16 + 8); }
    const bf16_t* gp0 = projb + (size_t)(c * 128 + i_row) * NP + C_RG + hd * 128 + 4 * fq;
#pragma unroll
    for (int n = 0; n < 8; ++n) gv8[n] = *(const uint2*)(gp0 + 16 * n);
  }
  {
    bf16x8 aq[4];
#pragma unroll
    for (int ks = 0; ks < 4; ++ks) aq[ks] = ldf(sQ, LD, 16 * wid, 32 * ks, fr, fq);
#pragma unroll
    for (int n = 0; n < 8; ++n) {
      if (n <= (wid | 1)) {
        uint2 w; w.x = 0u; w.y = 0u;
        if (n <= wid) {
          f32x4 s = (f32x4){0.f, 0.f, 0.f, 0.f};
#pragma unroll
          for (int ks = 0; ks < 4; ++ks) s = mmaT(aq[ks], ldf(sK, LD, 16 * n, 32 * ks, fr, fq), s);
          float r[4];
#pragma unroll
          for (int j = 0; j < 4; ++j) { const int d = i_row - (16 * n + 4 * fq + j); r[j] = (d >= 0) ? s[j] * __expf(lg * (float)d) : 0.f; }
          w.x = pk2(r[0], r[1]); w.y = pk2(r[2], r[3]);
        }
        *(uint2*)(sS + i_row * LD + 16 * n + 4 * fq) = w;
      }
    }
  }
  f32x4 o1[8];
#pragma unroll
  for (int n = 0; n < 8; ++n) o1[n] = (f32x4){0.f, 0.f, 0.f, 0.f};
  const int nks = (wid >> 1) + 1;
  for (int ks = 0; ks < nks; ++ks) {
    const bf16x8 a = ldf(sS, LD, 16 * wid, 32 * ks, fr, fq);
#pragma unroll
    for (int n = 0; n < 8; ++n) o1[n] = mmaT(a, frag_tr(sVt, LD, 32 * ks, 16 * n, fr, fq), o1[n]);
  }
  __syncthreads();
  {
    { const int e0 = tid >> 3, dg = tid & 7;
      *(uint4*)(sK + e0 * LD + dg * 16) = stv0; *(uint4*)(sK + e0 * LD + dg * 16 + 8) = stv1;
      *(uint4*)(sK + (e0 + 64) * LD + dg * 16) = stv2; *(uint4*)(sK + (e0 + 64) * LD + dg * 16 + 8) = stv3; }
  }
  __syncthreads();
  f32x4 o2[8];
#pragma unroll
  for (int n = 0; n < 8; ++n) o2[n] = (f32x4){0.f, 0.f, 0.f, 0.f};
#pragma unroll
  for (int ks = 0; ks < 4; ++ks) {
    const bf16x8 a = ldf(sQ, LD, 16 * wid, 32 * ks, fr, fq);
#pragma unroll
    for (int n = 0; n < 8; ++n) o2[n] = mmaT(a, ldf(sK, LD, 16 * n, 32 * ks, fr, fq), o2[n]);
  }
  const float dq = __expf(lg * (float)(i_row + 1));
  float ss = 0.f;
#pragma unroll
  for (int n = 0; n < 8; ++n)
#pragma unroll
    for (int j = 0; j < 4; ++j) { const float v = o1[n][j] + o2[n][j] * dq; o1[n][j] = v; ss += v * v; }
  ss += shx(ss, 16, lane); ss += shx(ss, 32, lane);
  const float rinv = rsqrtf(ss * (1.0f / 128.0f) + EPS);
  bf16_t* gp = projb + (size_t)(c * 128 + i_row) * NP + C_RG + hd * 128 + 4 * fq;
#pragma unroll
  for (int n = 0; n < 8; ++n) {
    const uint2 gv = gv8[n];
    uint2 w;
    w.x = pk2(o1[n][0] * rinv * silu_f(bflo(gv.x)), o1[n][1] * rinv * silu_f(bfhi(gv.x)));
    w.y = pk2(o1[n][2] * rinv * silu_f(bflo(gv.y)), o1[n][3] * rinv * silu_f(bfhi(gv.y)));
    if (!dry || rinv == 1.2345e-30f) *(uint2*)(gp + 16 * n) = w;
  }
  __syncthreads();
}

DI void ssd_out_unit(const Params& p, int layer, int hf, int bl, int c, unsigned char* shm, int tid, bool dry = false) {
  unsigned char* wsb = ows(p);
  constexpr int LXS = 72;
  bf16_t* sC = (bf16_t*)shm; bf16_t* sB = sC + 128 * LD; bf16_t* sM = sB; bf16_t* sX = sB + 128 * LD; bf16_t* sSp = sX + 128 * LXS;
  float* sDt = (float*)(sSp + 64 * LD); float* sAc = sDt + 16 * 128;
  bf16_t* projb = (bf16_t*)(wsb + WS_PROJ) + (size_t)bl * SEQ * NP;
  const bf16_t* xcb = (const bf16_t*)(wsb + WS_XC) + (size_t)(bl * SEQ + c * 128) * 1536;
  const float* tail = (const float*)(wsb + WS_TAIL) + (size_t)((hf * 2 + bl) * SEQ + c * 128) * 24;
  const int wid = tid >> 6, lane = tid & 63, fr = lane & 15, fq = lane >> 4;
  const int i_row = 16 * wid + fr;
#pragma unroll
  for (int q = 0; q < 2; ++q) {
    const int h = 2 * wid + q; const float Ah = -__expf(p.a_log[layer * 16 + h]);
    const float d0 = tail[(2 * lane) * 24 + h], d1 = tail[(2 * lane + 1) * 24 + h];
    float c0, c1, last; wave_cumsum128(d0 * Ah, d1 * Ah, lane, c0, c1, last);
    sDt[h * 128 + 2 * lane] = d0; sDt[h * 128 + 2 * lane + 1] = d1; sAc[h * 128 + 2 * lane] = c0; sAc[h * 128 + 2 * lane + 1] = c1;
  }
  float ssq = 0.f;
  for (int g = 0; g < 2; ++g) {
    __syncthreads();
#pragma unroll
    for (int it = 0; it < 4; ++it) {
      const int idx = tid + it * NTHR, j = idx >> 4, ng = idx & 15;
      *(uint4*)(sC + j * LD + ng * 8) = *(const uint4*)(xcb + (size_t)j * 1536 + 1280 + g * 128 + ng * 8);
      *(uint4*)(sB + j * LD + ng * 8) = *(const uint4*)(xcb + (size_t)j * 1536 + 1024 + g * 128 + ng * 8);
    }
    __syncthreads();
    f32x4 cbv[8];
    {
      bf16x8 ac[4];
#pragma unroll
      for (int ks = 0; ks < 4; ++ks) ac[ks] = ldf(sC, LD, 16 * wid, 32 * ks, fr, fq);
#pragma unroll
      for (int n = 0; n < 8; ++n) {
        cbv[n] = (f32x4){0.f, 0.f, 0.f, 0.f};
        if (n <= wid) {
#pragma unroll
          for (int ks = 0; ks < 4; ++ks) cbv[n] = mmaT(ac[ks], ldf(sB, LD, 16 * n, 32 * ks, fr, fq), cbv[n]);
        }
      }
    }
    __syncthreads();
    uint4 xr0, xr1, sr0, sr1;
    const int xj0 = tid >> 3, xpg = tid & 7;
    {
      const int h0 = g * 8;
      xr0 = *(const uint4*)(xcb + (size_t)xj0 * 1536 + h0 * 64 + xpg * 8); xr1 = *(const uint4*)(xcb + (size_t)(xj0 + 64) * 1536 + h0 * 64 + xpg * 8);
      const bf16_t* st = (const bf16_t*)(wsb + WS_SSTP + (size_t)hf * HROWS * DM * 2) + (size_t)((bl * 64 + c) * 16 + h0) * 8192 + xj0 * 128 + xpg * 16;
      sr0 = *(const uint4*)(st); sr1 = *(const uint4*)(st + 8);
    }
    for (int hh = 0; hh < 8; ++hh) {
      const int h = g * 8 + hh;
      *(uint4*)(sX + xj0 * LXS + xpg * 8) = xr0; *(uint4*)(sX + (xj0 + 64) * LXS + xpg * 8) = xr1;
      *(uint4*)(sSp + xj0 * LD + xpg * 16) = sr0; *(uint4*)(sSp + xj0 * LD + xpg * 16 + 8) = sr1;
      {
        const int h1 = (hh + 1 < 8) ? h + 1 : h;
        xr0 = *(const uint4*)(xcb + (size_t)xj0 * 1536 + h1 * 64 + xpg * 8); xr1 = *(const uint4*)(xcb + (size_t)(xj0 + 64) * 1536 + h1 * 64 + xpg * 8);
        const bf16_t* st = (const bf16_t*)(wsb + WS_SSTP + (size_t)hf * HROWS * DM * 2) + (size_t)((bl * 64 + c) * 16 + h1) * 8192 + xj0 * 128 + xpg * 16;
        sr0 = *(const uint4*)(st); sr1 = *(const uint4*)(st + 8);
      }
      const float ac_i = sAc[h * 128 + i_row];
#pragma unroll
      for (int n = 0; n < 8; ++n) {
        if (n <= (wid | 1)) {
          uint2 w; w.x = 0u; w.y = 0u;
          if (n <= wid) {
            const float4 acj = *(const float4*)(sAc + h * 128 + 16 * n + 4 * fq), dtj = *(const float4*)(sDt + h * 128 + 16 * n + 4 * fq);
            const int j0 = 16 * n + 4 * fq;
            const float r0 = (j0 + 0 <= i_row) ? cbv[n][0] * __expf(ac_i - acj.x) * dtj.x : 0.f;
            const float r1 = (j0 + 1 <= i_row) ? cbv[n][1] * __expf(ac_i - acj.y) * dtj.y : 0.f;
            const float r2 = (j0 + 2 <= i_row) ? cbv[n][2] * __expf(ac_i - acj.z) * dtj.z : 0.f;
            const float r3 = (j0 + 3 <= i_row) ? cbv[n][3] * __expf(ac_i - acj.w) * dtj.w : 0.f;
            w.x = pk2(r0, r1); w.y = pk2(r2, r3);
          }
          *(uint2*)(sM + i_row * LD + 16 * n + 4 * fq) = w;
        }
      }
      bf16_t* zp = projb + (size_t)(c * 128 + i_row) * NP + C_Z + h * 64 + 4 * fq;
      uint2 zv4[4];
#pragma unroll
      for (int m = 0; m < 4; ++m) zv4[m] = *(const uint2*)(zp + 16 * m);
      __syncthreads();
      f32x4 y[4], y2[4];
#pragma unroll
      for (int m = 0; m < 4; ++m) { y[m] = (f32x4){0.f, 0.f, 0.f, 0.f}; y2[m] = (f32x4){0.f, 0.f, 0.f, 0.f}; }
      const int nks = (wid >> 1) + 1;
      for (int ks = 0; ks < nks; ++ks) {
        const bf16x8 a = ldf(sM, LD, 16 * wid, 32 * ks, fr, fq);
#pragma unroll
        for (int m = 0; m < 4; ++m) y[m] = mmaT(a, frag_tr(sX, LXS, 32 * ks, 16 * m, fr, fq), y[m]);
      }
#pragma unroll
      for (int ks = 0; ks < 4; ++ks) {
        const bf16x8 a = ldf(sC, LD, 16 * wid, 32 * ks, fr, fq);
#pragma unroll
        for (int m = 0; m < 4; ++m) y2[m] = mmaT(a, ldf(sSp, LD, 16 * m, 32 * ks, fr, fq), y2[m]);
      }
      const float ei = __expf(ac_i), Dh = p.d_skip[layer * 16 + h];
#pragma unroll
      for (int m = 0; m < 4; ++m) {
        const uint2 zv = zv4[m];
        const uint2 xv = *(const uint2*)(sX + i_row * LXS + 16 * m + 4 * fq);
        const float zz[4] = {bflo(zv.x), bfhi(zv.x), bflo(zv.y), bfhi(zv.y)};
        const float xs[4] = {bflo(xv.x), bfhi(xv.x), bflo(xv.y), bfhi(xv.y)};
        float r[4];
#pragma unroll
        for (int j = 0; j < 4; ++j) {
          const float v = (y[m][j] + ei * y2[m][j] + Dh * xs[j]) * silu_f(zz[j]);
          r[j] = v; ssq += v * v;
        }
        uint2 w; w.x = pk2(r[0], r[1]); w.y = pk2(r[2], r[3]);
        if (!dry || ssq == 1.2345e-30f) *(uint2*)(zp + 16 * m) = w;
      }
      __syncthreads();
    }
  }
  ssq += shx(ssq, 16, lane); ssq += shx(ssq, 32, lane);
  const float rinv = rsqrtf(ssq * (1.0f / 1024.0f) + EPS);
  const float* gn = p.ssd_norm_g + layer * 1024;
  bf16_t* zr = projb + (size_t)(c * 128 + i_row) * NP + C_Z + 4 * fq;
  for (int t0 = 0; t0 < 64; t0 += 8) {
    uint2 v8[8]; float4 g8[8];
#pragma unroll
    for (int q = 0; q < 8; ++q) { v8[q] = *(const uint2*)(zr + 16 * (t0 + q)); g8[q] = *(const float4*)(gn + 16 * (t0 + q) + 4 * fq); }
#pragma unroll
    for (int q = 0; q < 8; ++q) {
      uint2 w; w.x = pk2(bflo(v8[q].x) * rinv * g8[q].x, bfhi(v8[q].x) * rinv * g8[q].y); w.y = pk2(bflo(v8[q].y) * rinv * g8[q].z, bfhi(v8[q].y) * rinv * g8[q].w);
      *(uint2*)(zr + 16 * (t0 + q)) = w;
    }
  }
  __syncthreads();
}

template <bool DIAG>
DI void fox_tile(const bf16_t* sK, const bf16_t* sV, const float* sFk, const bf16x8 (&qf)[2][2], f32x4 (&o)[2][4], float (&mrun)[2], float (&lsum)[2], int key0, int qg0, int fr, int fq, int lane) {
  const float SC2 = 0.125f * LOG2E;
  f32x4 s[2][4];
  const int kof = (fr * 64 + fq * 16) ^ ((fr >> 3) << 5);
#pragma unroll
  for (int t = 0; t < 4; ++t) {
    const bf16x8 k0 = *(const bf16x8*)((const unsigned char*)sK + (t * 2) * 1024 + kof), k1 = *(const bf16x8*)((const unsigned char*)sK + (t * 2 + 1) * 1024 + kof);
#pragma unroll
    for (int mi = 0; mi < 2; ++mi) { s[mi][t] = mmaT(qf[mi][0], k0, (f32x4){0.f, 0.f, 0.f, 0.f}); s[mi][t] = mmaT(qf[mi][1], k1, s[mi][t]); }
  }
  f32x4 fk[4];
#pragma unroll
  for (int t = 0; t < 4; ++t) fk[t] = *(const f32x4*)(sFk + 16 * t + 4 * fq);
  __builtin_amdgcn_sched_barrier(0);
  bf16x8 vf[2][4];
#pragma unroll
  for (int k2 = 0; k2 < 2; ++k2)
#pragma unroll
    for (int d = 0; d < 4; ++d) {
      const bf16_t* a = sV + (32 * k2 + 4 * fq + (fr >> 2)) * 72 + 16 * d + 4 * (fr & 3);
      const v4i16_t lo = tr_rd(a), hi = tr_rd(a + 16 * 72);
      vf[k2][d] = __builtin_shufflevector(lo, hi, 0, 1, 2, 3, 4, 5, 6, 7);
    }
  __builtin_amdgcn_sched_barrier(0);
#pragma unroll
  for (int mi = 0; mi < 2; ++mi) {
    float mx = -INFINITY;
#pragma unroll
    for (int t = 0; t < 4; ++t)
#pragma unroll
      for (int j = 0; j < 4; ++j) {
        float x = __builtin_fmaf(s[mi][t][j], SC2, fk[t][j]);
        if (DIAG) { if (key0 + 16 * t + 4 * fq + j > qg0 + 16 * mi) x = -INFINITY; }
        s[mi][t][j] = x; mx = fmaxf(mx, x);
      }
    mx = fmaxf(mx, shx(mx, 16, lane)); mx = fmaxf(mx, shx(mx, 32, lane));
    const float mnew = fmaxf(mrun[mi], mx), alpha = ex2(mrun[mi] - mnew);
    mrun[mi] = mnew;
    float ps = 0.f;
#pragma unroll
    for (int t = 0; t < 4; ++t)
#pragma unroll
      for (int j = 0; j < 4; ++j) { const float pv = ex2(s[mi][t][j] - mnew); s[mi][t][j] = pv; ps += pv; }
    lsum[mi] = lsum[mi] * alpha + ps;
#pragma unroll
    for (int d = 0; d < 4; ++d) o[mi][d] *= alpha;
  }
#pragma unroll
  for (int k2 = 0; k2 < 2; ++k2) {
    bf16x8 pa[2];
#pragma unroll
    for (int mi = 0; mi < 2; ++mi) pa[mi] = mk8(pk2(s[mi][2 * k2][0], s[mi][2 * k2][1]), pk2(s[mi][2 * k2][2], s[mi][2 * k2][3]), pk2(s[mi][2 * k2 + 1][0], s[mi][2 * k2 + 1][1]), pk2(s[mi][2 * k2 + 1][2], s[mi][2 * k2 + 1][3]));
#pragma unroll
    for (int d = 0; d < 4; ++d) {
#pragma unroll
      for (int mi = 0; mi < 2; ++mi) o[mi][d] = mmaT(pa[mi], vf[k2][d], o[mi][d]);
    }
  }
}

DI void fox_unit(const Params& p, int hf, int bl, int fh, int qb, unsigned char* shm, int tid, bool dry = false) {
  unsigned char* wsb = ows(p);
  constexpr int STG = 64 * 72 * 2 * 2 + 256;
  bf16_t* projb = (bf16_t*)(wsb + WS_PROJ) + (size_t)bl * SEQ * NP;
  const float* F = (const float*)(wsb + WS_FC) + (size_t)(bl * 8 + fh) * SEQ;
  const int wid = tid >> 6, lane = tid & 63, fr = lane & 15, fq = lane >> 4;
  const int q0 = qb * 256, qg0 = q0 + wid * 32 + fr;
  bf16x8 qf[2][2];
#pragma unroll
  for (int mi = 0; mi < 2; ++mi)
#pragma unroll
    for (int ks = 0; ks < 2; ++ks) {
      const uint4 raw = *(const uint4*)(projb + (size_t)(qg0 + 16 * mi) * NP + C_FQ + fh * 64 + ks * 32 + fq * 8);
      qf[mi][ks] = __builtin_bit_cast(bf16x8, raw);
    }
  float qmax2 = 0.f;
#pragma unroll
  for (int mi = 0; mi < 2; ++mi) {
    float ssum = 0.f;
#pragma unroll
    for (int ks = 0; ks < 2; ++ks) { float f[8]; unpack8(__builtin_bit_cast(uint4, qf[mi][ks]), f);
#pragma unroll
      for (int z = 0; z < 8; ++z) ssum += f[z] * f[z]; }
    ssum += shx(ssum, 16, lane); ssum += shx(ssum, 32, lane);
    qmax2 = fmaxf(qmax2, ssum);
  }
#pragma unroll
  for (int o_ = 8; o_ >= 1; o_ >>= 1) qmax2 = fmaxf(qmax2, shx(qmax2, o_, lane));
  float* sRed = (float*)(shm + 2 * STG);
  if (lane == 0) sRed[wid] = qmax2;
  const float Fref = F[q0];
  __syncthreads();
  float qm2 = 0.f;
#pragma unroll
  for (int i = 0; i < 8; ++i) qm2 = fmaxf(qm2, sRed[i]);
  const float kmax2 = ((const float*)(wsb + WS_KMAX))[bl * 8 + fh];
  const float thr = -110.0f - 0.25f * sqrtf(qm2 * kmax2) * 1.02f;
  const int nkt = 4 * qb + 4;
  int skip = 0;
  if (tid < 4 * qb) skip = (Fref - F[tid * 64 + 63] < thr) ? 1 : 0;
  const unsigned long long bal = __builtin_amdgcn_ballot_w64(skip != 0);
  if (lane == 0) ((int*)sRed)[8 + wid] = __builtin_popcountll(bal);
  __syncthreads();
  int kt0 = 0;
#pragma unroll
  for (int i = 0; i < 8; ++i) kt0 += ((const int*)sRed)[8 + i];
  f32x4 o[2][4];
#pragma unroll
  for (int mi = 0; mi < 2; ++mi)
#pragma unroll
    for (int d = 0; d < 4; ++d) o[mi][d] = (f32x4){0.f, 0.f, 0.f, 0.f};
  float mrun[2] = {-1e30f, -1e30f}, lsum[2] = {0.f, 0.f};
  const int skey = tid >> 3, sdg = tid & 7;
  const int kst = ((skey >> 4) * 2 + (sdg >> 2)) * 1024 + ((((skey & 15) * 64) + (sdg & 3) * 16) ^ (((skey >> 3) & 1) << 5));
  uint4 kreg, vreg; float freg = 0.f;
  {
    const size_t r = (size_t)(kt0 * 64 + skey) * NP;
    kreg = *(const uint4*)(projb + r + C_FK + fh * 64 + sdg * 8); vreg = *(const uint4*)(projb + r + C_FV + fh * 64 + sdg * 8);
    if (tid < 64) freg = (Fref - F[kt0 * 64 + tid]) * LOG2E;
  }
  {
    bf16_t* sK = (bf16_t*)(shm + (kt0 & 1) * STG); bf16_t* sV = sK + 64 * 72; float* sFk = (float*)(sV + 64 * 72);
    *(uint4*)((unsigned char*)sK + kst) = kreg; *(uint4*)(sV + skey * 72 + sdg * 8) = vreg;
    if (tid < 64) sFk[tid] = freg;
  }
  __syncthreads();
  for (int kt = kt0; kt < nkt; ++kt) {
    const int st = kt & 1;
    if (kt + 1 < nkt) {
      const size_t r = (size_t)((kt + 1) * 64 + skey) * NP;
      kreg = *(const uint4*)(projb + r + C_FK + fh * 64 + sdg * 8); vreg = *(const uint4*)(projb + r + C_FV + fh * 64 + sdg * 8);
      if (tid < 64) freg = (Fref - F[(kt + 1) * 64 + tid]) * LOG2E;
    }
    const bf16_t* sK = (const bf16_t*)(shm + st * STG); const bf16_t* sV = sK + 64 * 72; const float* sFk = (const float*)(sV + 64 * 72);
    if (kt * 64 <= q0 + wid * 32 + 31) {
      if (kt >= 4 * qb) fox_tile<true>(sK, sV, sFk, qf, o, mrun, lsum, kt * 64, qg0, fr, fq, lane);
      else fox_tile<false>(sK, sV, sFk, qf, o, mrun, lsum, kt * 64, qg0, fr, fq, lane);
    }
    if (kt + 1 < nkt) {
      bf16_t* nK = (bf16_t*)(shm + (st ^ 1) * STG); bf16_t* nV = nK + 64 * 72; float* nF = (float*)(nV + 64 * 72);
      *(uint4*)((unsigned char*)nK + kst) = kreg; *(uint4*)(nV + skey * 72 + sdg * 8) = vreg;
      if (tid < 64) nF[tid] = freg;
    }
    __syncthreads();
  }
#pragma unroll
  for (int mi = 0; mi < 2; ++mi) {
    float l = lsum[mi]; l += shx(l, 16, lane); l += shx(l, 32, lane);
    const float inv = 1.0f / l;
    bf16_t* gp = projb + (size_t)(qg0 + 16 * mi) * NP + C_FG + fh * 64 + 4 * fq;
#pragma unroll
    for (int d = 0; d < 4; ++d) {
      const uint2 gv = *(const uint2*)(gp + 16 * d);
      uint2 w;
      w.x = pk2(o[mi][d][0] * inv * silu_f(bflo(gv.x)), o[mi][d][1] * inv * silu_f(bfhi(gv.x)));
      w.y = pk2(o[mi][d][2] * inv * silu_f(bflo(gv.y)), o[mi][d][3] * inv * silu_f(bfhi(gv.y)));
      if (!dry || inv == 1.2345e-30f) *(uint2*)(gp + 16 * d) = w;
    }
  }
}

#define XB_TMO      128
#define XB_XCNT(j)  (256  + 64 * (j))
#define XB_XSUB(j)  (1280 + 64 * (j))
#define XB_XGEN(j)  (2304 + 64 * (j))
#define XB_TOP      3328
#define XB_TOPGEN   3392
#define XCD_BAR_WORDS 3456
#define XB_SPIN_CAP (1u << 20)
DI unsigned xb_ld(unsigned* p) { return __hip_atomic_load(p, __ATOMIC_RELAXED, __HIP_MEMORY_SCOPE_AGENT); }
DI unsigned xb_add(unsigned* p, unsigned v) { return __hip_atomic_fetch_add(p, v, __ATOMIC_RELAXED, __HIP_MEMORY_SCOPE_AGENT); }
DI unsigned xb_xcc_id() { return (unsigned)__builtin_amdgcn_s_getreg((3 << 11) | 20) & 0xFu; }
#define XB_SPIN(cond, bar) do { unsigned _sp = 0; while (cond) { __builtin_amdgcn_s_sleep(1); \
    if ((++_sp & 255u) == 0u) { if (xb_ld(&(bar)[XB_TMO])) break; if (_sp > XB_SPIN_CAP) { atomicAdd(&(bar)[XB_TMO], 1u); break; } } } } while (0)
struct XcdBarrier { unsigned* bar; unsigned x; volatile LDSP unsigned* st; };
DI XcdBarrier xcd_barrier_post(unsigned* bar, volatile LDSP unsigned* st) {
  XcdBarrier b; b.bar = bar; b.x = xb_xcc_id(); b.st = st;
  if (threadIdx.x == 0) (void)xb_add(&bar[XB_XCNT(b.x)], 1u);
  return b;
}
DI void xcd_barrier_complete(unsigned* bar, unsigned x, unsigned& nloc, unsigned& nx) {
  const unsigned G = gridDim.x;
  unsigned sum, cnt, mine, sp = 0u;
  for (;;) {
    sum = 0u; cnt = 0u; mine = 0u;
#pragma unroll
    for (unsigned j = 0; j < 16; ++j) { const unsigned c = xb_ld(&bar[XB_XCNT(j)]); sum += c; cnt += (c > 0u) ? 1u : 0u; mine = (j == x) ? c : mine; }
    if (sum == G) break;
    __builtin_amdgcn_s_sleep(1);
    if ((++sp & 255u) == 0u) { if (xb_ld(&bar[XB_TMO])) break; if (sp > XB_SPIN_CAP) { atomicAdd(&bar[XB_TMO], 1u); break; } }
  }
  nloc = mine > 0u ? mine : 1u; nx = cnt > 0u ? cnt : 1u;
}
DI void xcd_barrier(const XcdBarrier& b) {
  asm volatile("s_waitcnt vmcnt(0)" ::: "memory");
  __syncthreads();
  if (threadIdx.x == 0) {
    unsigned* bar = b.bar;
    __builtin_amdgcn_s_waitcnt(0);
    unsigned nloc = b.st[0], nx = b.st[1];
    if (nloc == 0u) { xcd_barrier_complete(bar, b.x, nloc, nx); b.st[0] = nloc; b.st[1] = nx; }
    const unsigned old = xb_add(&bar[XB_XSUB(b.x)], 1u);
    const unsigned gen = old / nloc;
    if (old + 1u == (gen + 1u) * nloc) {
      __builtin_amdgcn_fence(__ATOMIC_RELEASE, "agent");
      asm volatile("s_waitcnt vmcnt(0)" ::: "memory");
      const unsigned og = xb_add(&bar[XB_TOP], 1u);
      const unsigned tg = og / nx;
      if (og + 1u == (tg + 1u) * nx) xb_add(&bar[XB_TOPGEN], 1u);
      else XB_SPIN(xb_ld(&bar[XB_TOPGEN]) == tg, bar);
      __builtin_amdgcn_fence(__ATOMIC_ACQUIRE, "agent");
      xb_add(&bar[XB_XGEN(b.x)], 1u);
      asm volatile("s_waitcnt vmcnt(0)" ::: "memory");
    } else {
      XB_SPIN(xb_ld(&bar[XB_XGEN(b.x)]) == gen, bar);
      __builtin_amdgcn_fence(__ATOMIC_ACQUIRE, "agent");
      asm volatile("s_waitcnt vmcnt(0)" ::: "memory");
    }
  }
  __syncthreads();
}

DI int otid_(int wbase) { int t = wbase + (int)__builtin_amdgcn_mbcnt_hi(~0u, __builtin_amdgcn_mbcnt_lo(~0u, 0u)); asm volatile("" : "+v"(t)); return t; }
#define otid() otid_(wbase)
__global__ void __launch_bounds__(NTHR) mega(Params p) {
  extern __shared__ __attribute__((aligned(16))) unsigned char shm[];
  __shared__ uint4 s_words[2];
#define s_unit (*(int*)&s_words[1])
  cg::grid_group grid = cg::this_grid();
  const int wbase = __builtin_amdgcn_readfirstlane((int)(threadIdx.x & ~63u));
  const int tid = threadIdx.x;
  if (tid == 0) { s_words[0] = make_uint4(0u, 0u, 0u, 0u); s_words[1] = make_uint4(0u, 0u, 0u, 0u); }
  __syncthreads();
  int* ctr = (int*)(p.ws + WS_CTR);
  int phase_id = 0;
  (void)xcd_barrier_post((unsigned*)(ows(p) + WS_BAR), (volatile LDSP unsigned*)&s_words[0]);
  if (p.ws == nullptr) grid.sync();
#ifndef X_P0
  phase0(p, shm, otid());
#endif
#define GSYNC() do { XcdBarrier xb_; xb_.bar = (unsigned*)(ows(p) + WS_BAR); xb_.x = xb_xcc_id(); xb_.st = (volatile LDSP unsigned*)&s_words[0]; xcd_barrier(xb_); } while (0)
#if defined(PROBE_SYNC)
  for (int i = 0; i < 45; ++i) GSYNC();
#endif
  GSYNC();
  for (int layer = 0; layer < NLAYER; ++layer) {
    if (layer == 0) { norm_phase(p, 0, otid()); GSYNC(); }
    for (int hf = 0; hf < 2; ++hf) {
#ifndef X_G0
      gemm_phase<0>(p, layer, hf, shm, otid());
#endif
#if defined(PROBE_G0)
      gemm_phase<0>(p, layer, hf, shm, otid());
#endif
      GSYNC();
#if defined(PROBE_P2)
      for (int u = 16 + blockIdx.x; u < 16 + 256 + 512; u += gridDim.x) {
        if (u < 272) { const int k = u - 16; ssd_local_unit(p, layer, hf, k >> 7, (k >> 1) & 63, k & 1, shm, otid()); }
        else { const int k = u - 272; ret_local_unit(p, hf, k >> 8, (k >> 2) & 63, k & 3, shm, otid()); }
      }
#endif
      {
        int* my = ctr + 8 + phase_id;
        for (;;) {
          __syncthreads();
          if (otid() == 0) s_unit = atomicAdd(my, 1);
          __syncthreads();
          const int u0 = s_unit;
          const int n_fill = (hf == 0 && layer > 0) ? 256 : 0;
          int u = u0;
          if (u >= 784 + n_fill) break;
          if (u >= 16 && u < 16 + n_fill) { norm_unit(p, layer, 1, u - 16, otid()); continue; }
          if (u >= 16) u -= n_fill;
          if (u < 16) fox_cumsum_unit(p, hf, u >> 3, u & 7, shm, otid());
          else if (u < 272) { const int k = u - 16; ssd_local_unit(p, layer, hf, k >> 7, (k >> 1) & 63, k & 1, shm, otid()); }
          else { const int k = u - 272; ret_local_unit(p, hf, k >> 8, (k >> 2) & 63, k & 3, shm, otid()); }
        }
      }
      GSYNC();
      {
        int* my = ctr + phase_id; int* dep = ctr + 64 + phase_id; ++phase_id;
        bool dep_ok = false;
        for (;;) {
          __syncthreads();
          if (otid() == 0) s_unit = atomicAdd(my, 1);
          __syncthreads();
          const int u0 = s_unit;
          const int n_fill = (hf == 1) ? 256 : 0;
          int u = u0;
          if (u >= 1344 + n_fill) break;
          if (u >= 448 && u < 448 + n_fill) { norm_unit(p, layer + 1, 0, u - 448, otid()); continue; }
          if (u >= 448) u -= n_fill;
          const bool needs = (u >= 448 && u < 576) || (u >= 832);
          if (needs && !dep_ok) {
            if (otid() == 0) {
              unsigned sp = 0;
              while (__hip_atomic_load(dep, __ATOMIC_RELAXED, __HIP_MEMORY_SCOPE_AGENT) < 192) { __builtin_amdgcn_s_sleep(2); if (++sp > (1u << 22)) break; }
              __builtin_amdgcn_fence(__ATOMIC_ACQUIRE, "agent");
              asm volatile("s_waitcnt vmcnt(0)" ::: "memory");
            }
            __syncthreads();
            dep_ok = true;
          }
          if (u < 256) { fox_unit(p, hf, (u >> 3) & 1, u & 7, 31 - (u >> 4), shm, otid()); }
          else if (u < 448) {
            scan_unit(p, hf, u - 256, otid());
            asm volatile("s_waitcnt vmcnt(0)" ::: "memory");
            __syncthreads();
            if (otid() == 0) { __builtin_amdgcn_fence(__ATOMIC_RELEASE, "agent"); asm volatile("s_waitcnt vmcnt(0)" ::: "memory"); __hip_atomic_fetch_add(dep, 1, __ATOMIC_RELAXED, __HIP_MEMORY_SCOPE_AGENT); }
          }
          else if (u < 576) { const int k = u - 448; ssd_out_unit(p, layer, hf, k >> 6, k & 63, shm, otid()); }
          else if (u < 832) { const int k = u - 576 + 256; fox_unit(p, hf, (k >> 3) & 1, k & 7, 31 - (k >> 4), shm, otid()); }
          else { const int k = u - 832; ret_out_unit(p, hf, k >> 8, (k >> 2) & 63, k & 3, shm, otid()); }
        }
      }
      GSYNC();
#ifndef X_G1
      gemm_phase<1>(p, layer, hf, shm, otid());
#endif
      GSYNC();
    }
  }
  norm_rows(p, NLAYER, HROWS, HROWS, blockIdx.x * 8, gridDim.x * 8, otid());
}

extern "C" void kernel_launch(void* const* d_in, const int* in_sizes, int n_in, void* d_out, int out_size, void* d_ws, size_t ws_size, hipStream_t stream) {
  static int grid = 0;
  if (grid == 0) {
    int dev = 0, cus = 0, per_cu = 0;
    hipGetDevice(&dev);
    hipDeviceGetAttribute(&cus, hipDeviceAttributeMultiprocessorCount, dev);
    hipFuncSetAttribute((const void*)mega, hipFuncAttributeMaxDynamicSharedMemorySize, LDS_BYTES);
    if (hipOccupancyMaxActiveBlocksPerMultiprocessor(&per_cu, (const void*)mega, NTHR, LDS_BYTES) != hipSuccess || per_cu < 1) per_cu = 1;
    (void)hipGetLastError();
    grid = cus * per_cu;
    if (ws_size < WS_END || n_in != 16) { fprintf(stderr, "kernel_launch: workspace %zu < %zu or n_in %d != 16\n", ws_size, (size_t)WS_END, n_in); grid = -1; }
  }
  if (grid < 0) return;
  Params p{};
  p.x = (const float*)d_in[0]; p.c = (const float*)d_in[1]; p.pos = (const int*)d_in[2]; p.norm_g = (const float*)d_in[3];
  p.w_ada = (const float*)d_in[4]; p.b_ada = (const float*)d_in[5]; p.w_in = (const float*)d_in[6]; p.conv_w = (const float*)d_in[7];
  p.conv_b = (const float*)d_in[8]; p.dt_bias = (const float*)d_in[9]; p.a_log = (const float*)d_in[10]; p.d_skip = (const float*)d_in[11];
  p.ssd_norm_g = (const float*)d_in[12]; p.b_forget = (const float*)d_in[13]; p.w_out = (const float*)d_in[14]; p.final_g = (const float*)d_in[15];
  p.out = (float*)d_out; p.ws = (unsigned char*)d_ws;
  (void)hipMemsetAsync((char*)d_ws + WS_CTR, 0, 1024, stream);
  (void)hipMemsetAsync((char*)d_ws + WS_BAR, 0, 16384, stream);
  void* args[] = {&p};
  hipError_t e = hipLaunchCooperativeKernel((const void*)mega, dim3(grid), dim3(NTHR), args, LDS_BYTES, stream);
  if (e != hipSuccess) fprintf(stderr, "cooperative launch failed: %s (grid %d)\n", hipGetErrorString(e), grid);
}
```
